# Optimizing an MI355X kernel written in HIP

```python
import math
import jax, jax.numpy as jnp
from jax import lax
import numpy as np


D_MODEL = 1024
BATCH = 8
SEQ = 4096
DEPTH = 1

CHUNK = 64
Q_BLOCK = 128
MIX_WIDTH = D_MODEL
DA_WIDTH = MIX_WIDTH // 2
DA_HEADS = 4
DA_V_DIM = DA_WIDTH // DA_HEADS
DA_QK_DIM = DA_V_DIM // 2
RET_WIDTH = MIX_WIDTH - DA_WIDTH
RET_HEADS = 4
RET_V_DIM = RET_WIDTH // RET_HEADS
RET_QK_DIM = RET_V_DIM // 2
SPLIT_SIZES = (DA_HEADS * 2 * DA_QK_DIM, DA_HEADS * 2 * DA_QK_DIM, DA_HEADS * DA_V_DIM,
               RET_HEADS * RET_QK_DIM, RET_HEADS * RET_QK_DIM, RET_HEADS * RET_V_DIM,
               RET_HEADS * RET_V_DIM)
IN_WIDTH = sum(SPLIT_SIZES)
D_FF = ((8 * D_MODEL // 3 + 127) // 128) * 128
CONV_WIDTH = 3
N_MOD = 6
RMS_EPS = 1e-6

kernel_name = 'hybrid_diffattn_retention_convffn_block'


def rms_norm(x, gain=None):
    xf = x.astype(jnp.float32)
    y = xf * lax.rsqrt(jnp.mean(xf * xf, axis=-1, keepdims=True) + RMS_EPS)
    if gain is not None:
        y = y * gain.astype(jnp.float32)
    return y.astype(x.dtype)


def split_cols(p, sizes):
    idx = []
    acc = 0
    for s in sizes[:-1]:
        acc += s
        idx.append(acc)
    return jnp.split(p, idx, axis=-1)


def diff_attention(q, k, v, lam, subln_gain, lambda_init):
    B, S, H, _, dq = q.shape
    dv = v.shape[-1]
    n_qb = S // Q_BLOCK
    scale = dq ** -0.5
    slopes = 2.0 ** (-8.0 * (jnp.arange(H, dtype=jnp.float32) + 1.0) / H)
    k_pos = jnp.arange(S)
    k_chunk = k_pos // CHUNK
    q_blocks = q.reshape(B, n_qb, Q_BLOCK, H, 2, dq).transpose(1, 0, 2, 3, 4, 5)

    def block(args):
        qb, start = args
        q_pos = start + jnp.arange(Q_BLOCK)
        s = jnp.einsum('bqhmd,bkhmd->bhmqk', qb, k).astype(jnp.float32) * scale
        dist = jnp.abs(q_pos[:, None] - k_pos[None, :]).astype(jnp.float32)
        bias = -slopes[:, None, None] * dist[None]
        allowed = k_chunk[None, :] <= (q_pos // CHUNK)[:, None]
        s = jnp.where(allowed, s + bias[None, :, None], -jnp.inf)
        p = jax.nn.softmax(s, axis=-1)
        a = p[:, :, 0] - lam * p[:, :, 1]
        return jnp.einsum('bhqk,bkhe->bqhe', a.astype(v.dtype), v)

    starts = jnp.arange(n_qb, dtype=jnp.int32) * Q_BLOCK
    o = lax.map(block, (q_blocks, starts))
    o = o.transpose(1, 0, 2, 3, 4).reshape(B, S, H, dv)
    o = rms_norm(o, subln_gain) * (1.0 - lambda_init)
    return o.reshape(B, S, H * dv)


def retention(q, k, v, g):
    B, S, H, dk = q.shape
    dv = v.shape[-1]
    N = S // CHUNK
    dt = q.dtype
    log_gamma = jnp.log(1.0 - 2.0 ** (-5.0 - jnp.arange(H, dtype=jnp.float32)))
    idx = jnp.arange(CHUNK, dtype=jnp.float32)
    intra_decay = jnp.exp(log_gamma[:, None, None] * jnp.abs(idx[:, None] - idx[None, :]))
    in_decay = jnp.exp(log_gamma[:, None] * (CHUNK - 1.0 - idx)).T
    out_decay = jnp.exp(log_gamma[:, None] * (idx + 1.0)).T
    chunk_decay = jnp.exp(log_gamma * CHUNK)

    qc = q.reshape(B, N, CHUNK, H, dk)
    kc = k.reshape(B, N, CHUNK, H, dk) * (dk ** -0.5)
    vc = v.reshape(B, N, CHUNK, H, dv)

    s = jnp.einsum('bnihd,bnjhd->bnhij', qc, kc) * intra_decay.astype(dt)
    o_intra = jnp.einsum('bnhij,bnjhe->bnihe', s, vc)

    u = jnp.einsum('bnjhd,bnjhe->nbhde', kc * in_decay[:, :, None].astype(dt), vc).astype(jnp.float32)

    def step(state, u_n):
        return chunk_decay[None, :, None, None] * state + u_n, state

    _, s_prev = lax.scan(step, jnp.zeros((B, H, dk, dv), jnp.float32), u)
    o_cross = jnp.einsum('bnihd,nbhde->bnihe', qc * out_decay[:, :, None].astype(dt), s_prev.astype(dt))

    o = (o_intra + o_cross).reshape(B, S, H, dv)
    o = rms_norm(o).reshape(B, S, H * dv)
    return o * jax.nn.silu(g)


def causal_dwconv(h, w, b):
    K = w.shape[0]
    S = h.shape[1]
    hp = jnp.pad(h, ((0, 0), (K - 1, 0), (0, 0)))
    out = b
    for j in range(K):
        out = out + hp[:, j:j + S] * w[j]
    return out


def setup_inputs(seed: int = 0) -> dict:
    key = jax.random.key(seed)
    ks = jax.random.split(key, 20)

    def nrm(k, shape, scale):
        return jax.random.normal(k, shape, jnp.float32) * scale

    def gain(k, n):
        return 1.0 + nrm(k, (DEPTH, n), 0.02)

    return {
        'x': nrm(ks[0], (BATCH, SEQ, D_MODEL), 1.0),
        'c': nrm(ks[1], (BATCH, D_MODEL), 1.0),
        'w_ada': nrm(ks[2], (DEPTH, D_MODEL, N_MOD * D_MODEL), 0.5 * D_MODEL ** -0.5),
        'b_ada': nrm(ks[3], (DEPTH, N_MOD * D_MODEL), 0.01),
        'g_pre_mix': gain(ks[4], D_MODEL),
        'w_in': nrm(ks[5], (DEPTH, D_MODEL, IN_WIDTH), D_MODEL ** -0.5),
        'lam_q1': nrm(ks[6], (DEPTH, DA_QK_DIM), 0.1),
        'lam_k1': nrm(ks[7], (DEPTH, DA_QK_DIM), 0.1),
        'lam_q2': nrm(ks[8], (DEPTH, DA_QK_DIM), 0.1),
        'lam_k2': nrm(ks[9], (DEPTH, DA_QK_DIM), 0.1),
        'g_da_subln': gain(ks[10], DA_V_DIM),
        'w_out': nrm(ks[11], (DEPTH, MIX_WIDTH, D_MODEL), MIX_WIDTH ** -0.5),
        'g_post_mix': gain(ks[12], D_MODEL),
        'g_pre_ffn': gain(ks[13], D_MODEL),
        'w_up': nrm(ks[14], (DEPTH, D_MODEL, 2 * D_FF), D_MODEL ** -0.5),
        'conv_w': nrm(ks[15], (DEPTH, CONV_WIDTH, 2 * D_FF), CONV_WIDTH ** -0.5),
        'conv_b': nrm(ks[16], (DEPTH, 2 * D_FF), 0.01),
        'w_down': nrm(ks[17], (DEPTH, D_FF, D_MODEL), D_FF ** -0.5),
        'g_post_ffn': gain(ks[18], D_MODEL),
    }


def reference(x, c, w_ada, b_ada, g_pre_mix, w_in, lam_q1, lam_k1, lam_q2, lam_k2, g_da_subln,
              w_out, g_post_mix, g_pre_ffn, w_up, conv_w, conv_b, w_down, g_post_ffn):
    B, S, _ = x.shape
    for l in range(DEPTH):
        mod = jax.nn.silu(c) @ w_ada[l] + b_ada[l]
        sh1, sc1, gt1, sh2, sc2, gt2 = [m[:, None, :] for m in jnp.split(mod, N_MOD, axis=-1)]

        h = rms_norm(x, g_pre_mix[l]) * (1.0 + sc1) + sh1
        proj = h @ w_in[l]
        da_q, da_k, da_v, r_q, r_k, r_v, r_g = split_cols(proj, SPLIT_SIZES)

        lambda_init = 0.8 - 0.6 * math.exp(-0.3 * l)
        lam = (jnp.exp(jnp.sum(lam_q1[l].astype(jnp.float32) * lam_k1[l].astype(jnp.float32)))
               - jnp.exp(jnp.sum(lam_q2[l].astype(jnp.float32) * lam_k2[l].astype(jnp.float32)))
               + lambda_init)
        o_da = diff_attention(da_q.reshape(B, S, DA_HEADS, 2, DA_QK_DIM),
                              da_k.reshape(B, S, DA_HEADS, 2, DA_QK_DIM),
                              da_v.reshape(B, S, DA_HEADS, DA_V_DIM),
                              lam, g_da_subln[l], lambda_init)
        o_ret = retention(r_q.reshape(B, S, RET_HEADS, RET_QK_DIM),
                          r_k.reshape(B, S, RET_HEADS, RET_QK_DIM),
                          r_v.reshape(B, S, RET_HEADS, RET_V_DIM),
                          r_g)
        mix = jnp.concatenate([o_da, o_ret], axis=-1) @ w_out[l]
        x = x + gt1 * rms_norm(mix, g_post_mix[l])

        h = rms_norm(x, g_pre_ffn[l]) * (1.0 + sc2) + sh2
        u = causal_dwconv(h @ w_up[l], conv_w[l], conv_b[l])
        u_gate, u_val = jnp.split(u, 2, axis=-1)
        f = (jax.nn.silu(u_gate) * u_val) @ w_down[l]
        x = x + gt2 * rms_norm(f, g_post_ffn[l])
    return x
```

```cpp
#include <hip/hip_runtime.h>
#include <hip/hip_cooperative_groups.h>
#include <cstdio>
#include <cstdint>
#ifndef MK_N_LAUNCHES
#define MK_N_LAUNCHES 1
#endif
namespace pg8 {
#define PG8_LAS __attribute__((address_space(3)))
typedef unsigned short bf16_t;
typedef short bf16x8 __attribute__((ext_vector_type(8)));
typedef float f32x4 __attribute__((ext_vector_type(4)));
typedef unsigned u32x4 __attribute__((ext_vector_type(4)));
constexpr int BM = 256, BK = 64, HALF = 128, HTB = HALF * BK * 2  , STAGE_BYTES = 8 * HTB, NXCD = 8, WGM = 8;

__host__ __device__ __forceinline__ int lds_byte(int r, int c) { const int st = (r >> 4) * 2 + (c >> 5), rr = r & 15, cc = c & 31, ob = rr * 64 + cc * 2; return st * 1024 + (ob ^ (((ob >> 9) & 1) << 5)); }
__host__ __device__ __forceinline__ void stage_rc(int b, int& R, int& C) { const int st = b / 1024, sb = b % 1024, swz = sb ^ (((sb >> 9) & 1) << 5); R = (st >> 1) * 16 + swz / 64; C = (st & 1) * 32 + (swz % 64) / 2; }
__host__ __device__ __forceinline__ int perm32(int rho) { const int n = rho >> 4, i = rho & 15; return 8 * (i >> 2) + 4 * n + (i & 3); }

struct Unit { int pm, pn; };
struct Gemm { const bf16_t* A; const bf16_t* Bt; int M, N, K, lda; };

struct StaticOrder {
    int nM, nN, nwg, G, c, wgm;
    __host__ __device__ void init(int M, int N, int G_, int c_, int wgm_ = WGM) { nM = M / BM; nN = N / BM; nwg = nM * nN; G = G_; c = c_; wgm = wgm_; }
    __host__ __device__ bool next(int i, Unit& u) const {
        const long L = (long)i * G + c; if (L >= nwg) return false;
        int wgid = (int)L; { const int q = nwg / NXCD, r = nwg % NXCD, xcd = wgid % NXCD, off = wgid / NXCD; wgid = (xcd < r ? xcd * (q + 1) : r * (q + 1) + (xcd - r) * q) + off; }
        const int nig = wgm * nN, gid = wgid / nig, fm = gid * wgm, gsz = (nM - fm) < wgm ? (nM - fm) : wgm;
        u.pm = fm + ((wgid % nig) % gsz); u.pn = (wgid % nig) / gsz; return true;
    }
    __device__ __forceinline__ void a_ready(const Unit&) const {}
    __device__ __forceinline__ void done(const Unit&) const {}
};

__device__ __forceinline__ unsigned cvt_pk_bf16(float lo, float hi) { unsigned r; asm volatile("v_cvt_pk_bf16_f32 %0, %1, %2" : "=v"(r) : "v"(lo), "v"(hi)); return r; }

template <int CTRL> __device__ __forceinline__ float dpp_mov(float old, float src) {
    return __builtin_bit_cast(float, __builtin_amdgcn_update_dpp(__builtin_bit_cast(int, old), __builtin_bit_cast(int, src), CTRL, 0xf, 0xf, false)); }
__device__ __forceinline__ float silu_e(float v) { return v * __builtin_amdgcn_rcpf(1.f + __builtin_amdgcn_exp2f(-1.4426950408889634f * v)); }
typedef unsigned u32x2 __attribute__((ext_vector_type(2)));
struct EpiBf16 {
    static constexpr bool PERM = true, AFTER_DRAIN = false;
    bf16_t* O; int ldc; int scale_cols; float scale0; int mode; const float* cw; const float* cb; float* rawf; float* rawl; PG8_LAS float* xb;
    __device__ __forceinline__ void operator()(f32x4 (&acc)[2][2][4][2], const Unit& u, int wr, int wc, int fr, int fq) const {
      if (mode == 0) {
        const int row0 = u.pm * BM + wr * 64 + fr; const int colt = u.pn * BM;
        const float sc = (colt < scale_cols) ? scale0 : 1.f;
        const int col0 = colt + wc * 32 + 8 * fq;
#pragma unroll
        for (int ai = 0; ai < 2; ++ai)
#pragma unroll
            for (int m = 0; m < 4; ++m) { const int row = row0 + ai * HALF + m * 16; bf16_t* rowp = O + (size_t)row * ldc + col0;
#pragma unroll
                for (int bj = 0; bj < 2; ++bj) { f32x4 v0 = acc[ai][bj][m][0] * sc, v1 = acc[ai][bj][m][1] * sc;
                    u32x4 w; w.x = cvt_pk_bf16(v0[0], v0[1]); w.y = cvt_pk_bf16(v0[2], v0[3]); w.z = cvt_pk_bf16(v1[0], v1[1]); w.w = cvt_pk_bf16(v1[2], v1[3]);
                    *(u32x4*)(rowp + bj * HALF) = w; } }
      } else {
        const int R0 = u.pm * BM, colq = wc * 32 + 8 * fq, tcol = u.pn * BM; const bool bstart = (R0 & 4095) == 0;
        PG8_LAS f32x4* wt = (PG8_LAS f32x4*)(xb + 2048);
        f32x4 wld = (f32x4){0.f, 0.f, 0.f, 0.f};
        if (wr == 0) { const int pp = fr & 7, nn = fr >> 3, chn = u.pn * HALF + colq + 4 * nn;
            const float* src = (pp < 3) ? cw + pp * 5632 + chn : (pp == 3) ? cb + chn : (pp < 7) ? cw + (pp - 4) * 5632 + 2816 + chn : cb + 2816 + chn;
            wld = *(const f32x4*)src; }
        if (fr >= 14) {
#pragma unroll
            for (int ai = 0; ai < 2; ++ai)
#pragma unroll
                for (int bj = 0; bj < 2; ++bj)
#pragma unroll
                    for (int n = 0; n < 2; ++n) *(PG8_LAS f32x4*)(xb + ((ai * 2 + wr) * 2 + (fr - 14)) * 256 + bj * HALF + colq + 4 * n) = acc[ai][bj][3][n];
            if (wr == 1) {
#pragma unroll
                for (int bj = 0; bj < 2; ++bj)
#pragma unroll
                    for (int n = 0; n < 2; ++n) *(f32x4*)(rawl + ((size_t)u.pm * 2 + (fr - 14)) * 5632 + tcol + bj * HALF + colq + 4 * n) = acc[1][bj][3][n]; }
        }
        if (fr < 2 && wr == 0) {
#pragma unroll
            for (int bj = 0; bj < 2; ++bj)
#pragma unroll
                for (int n = 0; n < 2; ++n) *(f32x4*)(rawf + ((size_t)u.pm * 2 + fr) * 5632 + tcol + bj * HALF + colq + 4 * n) = acc[0][bj][0][n]; }
        if (wr == 0) wt[((wc * 4 + fq) * 2 + (fr >> 3)) * 8 + (fr & 7)] = wld;
        asm volatile("s_waitcnt lgkmcnt(0)" ::: "memory"); __builtin_amdgcn_s_barrier(); asm volatile("" ::: "memory");
#pragma unroll
        for (int n = 0; n < 2; ++n) {
            const int ch = u.pn * HALF + colq + 4 * n;
            f32x4 wg[3], wv[3];
#pragma unroll
            for (int j = 0; j < 3; ++j) { wg[j] = wt[((wc * 4 + fq) * 2 + n) * 8 + j]; wv[j] = wt[((wc * 4 + fq) * 2 + n) * 8 + 4 + j]; }
            const f32x4 bg = wt[((wc * 4 + fq) * 2 + n) * 8 + 3], bv = wt[((wc * 4 + fq) * 2 + n) * 8 + 7];
#pragma unroll
            for (int ai = 0; ai < 2; ++ai) {
                const int pb = ai * 2 + wr - 1;
#pragma unroll
                for (int m = 3; m >= 0; --m) {
                    float cg[4], cv[4];
#pragma unroll
                    for (int bj = 0; bj < 2; ++bj) {
                        const f32x4 cur = acc[ai][bj][m][n];
                        f32x4 p62 = (f32x4){0.f, 0.f, 0.f, 0.f}, p63 = p62;
                        if (m == 0 && pb >= 0) { p62 = *(const PG8_LAS f32x4*)(xb + (pb * 2 + 0) * 256 + bj * HALF + colq + 4 * n); p63 = *(const PG8_LAS f32x4*)(xb + (pb * 2 + 1) * 256 + bj * HALF + colq + 4 * n); }
#pragma unroll
                        for (int e = 0; e < 4; ++e) {
                            float o1, o2;
                            if (m > 0) { const float P = acc[ai][bj][m - 1][n][e]; o1 = dpp_mov<0x121>(P, P); o2 = dpp_mov<0x122>(P, P); }
                            else { o1 = p63[e]; o2 = (fr == 0) ? p62[e] : p63[e]; }
                            const float xm1 = dpp_mov<0x111>(o1, cur[e]), xm2 = dpp_mov<0x112>(o2, cur[e]);
                            const float c = bj ? (bv[e] + wv[0][e] * xm2 + wv[1][e] * xm1 + wv[2][e] * cur[e]) : (bg[e] + wg[0][e] * xm2 + wg[1][e] * xm1 + wg[2][e] * cur[e]);
                            if (bj) cv[e] = c; else cg[e] = c;
                        }
                    }
                    u32x2 w; w.x = cvt_pk_bf16(silu_e(cg[0]) * cv[0], silu_e(cg[1]) * cv[1]); w.y = cvt_pk_bf16(silu_e(cg[2]) * cv[2], silu_e(cg[3]) * cv[3]);
                    const int row = R0 + ai * HALF + wr * 64 + m * 16 + fr;
                    const bool skip = (ai == 0) && (m == 0) && (wr == 0) && (fr < 2) && !bstart;
                    if (!skip) *(u32x2*)(O + (size_t)row * ldc + ch) = w;
                }
            }
        }
      }
    }
};
template <class Epi, class Sched, bool ALIGN_EPI = false, bool SP2 = false>
__device__ __forceinline__ void gemm_phase(PG8_LAS unsigned char* lds, const Gemm g, const Sched& S, const Epi& E, const int tid_in) {
    const int tid = tid_in, wid = __builtin_amdgcn_readfirstlane(tid >> 6), lane = tid & 63, wr = wid >> 2, wc = wid & 3, fr = lane & 15, fq = lane >> 4;
    const int K = g.K, nt = K / BK;
    unsigned voffA[2], voffB[2];
#pragma unroll
    for (int i = 0; i < 2; ++i) { int R, C; stage_rc(tid * 16 + i * 8192, R, C); const int Rb = Epi::PERM ? ((R & ~31) + perm32(R & 31)) : R;
        voffA[i] = (unsigned)(R * g.lda + C) * 2u; voffB[i] = (unsigned)(Rb * K + C) * 2u; }
    const size_t kstep = (size_t)(BK * 2);
    const size_t hstepB = (size_t)HALF * K * 2, hstepA = (size_t)HALF * g.lda * 2;
    const size_t tstepA = 2 * hstepA, tstepB = 2 * hstepB;
    const unsigned ldsw = (unsigned)wid * 1024u;
    const int aoff = lds_byte(wr * 64 + fr, fq * 8), boff = lds_byte(wc * 32 + fr, fq * 8);
#define PG8_SA(b, h) (((b) * 2 + (h)) * HTB)
#define PG8_SB(b, h) ((4 + (b) * 2 + (h)) * HTB)
#define PG8_STAGE(bufoff, gbase, voff) do { _Pragma("unroll") for (int _i = 0; _i < 2; ++_i) \
        __builtin_amdgcn_global_load_lds((const unsigned*)((const char*)(gbase) + (voff)[_i]), (PG8_LAS unsigned*)(lds + (bufoff) + ldsw + _i * 8192), 16, 0, 0); } while (0)
#define PG8_LDA(dst, b, h) do { _Pragma("unroll") for (int m = 0; m < 4; ++m) _Pragma("unroll") for (int k = 0; k < 2; ++k) dst[m][k] = *(const PG8_LAS bf16x8*)(lds + PG8_SA(b, h) + aoff + m * 2048 + k * 1024); } while (0)
#define PG8_LDB(dst, b, h) do { _Pragma("unroll") for (int n = 0; n < 2; ++n) _Pragma("unroll") for (int k = 0; k < 2; ++k) dst[n][k] = *(const PG8_LAS bf16x8*)(lds + PG8_SB(b, h) + boff + n * 2048 + k * 1024); } while (0)
#define PG8_MMA(ai, bj, At, Bt) do { __builtin_amdgcn_s_setprio(1); _Pragma("unroll") for (int m = 0; m < 4; ++m) _Pragma("unroll") for (int n = 0; n < 2; ++n) _Pragma("unroll") for (int k = 0; k < 2; ++k) \
        acc[ai][bj][m][n] = __builtin_amdgcn_mfma_f32_16x16x32_bf16(Bt[n][k], At[m][k], acc[ai][bj][m][n], 0, 0, 0); __builtin_amdgcn_s_setprio(0); } while (0)
#define PG8_WAIT_V(n) asm volatile("s_waitcnt vmcnt(" #n ")" ::: "memory")
#define PG8_WAIT_L(n) asm volatile("s_waitcnt lgkmcnt(" #n ")" ::: "memory")
#define PG8_BAR __builtin_amdgcn_s_barrier()
#define PG8_SCHED __builtin_amdgcn_sched_barrier(0)
    Unit cur, nxt; int ui = 0;
    if (!S.next(0, cur)) return;
    f32x4 acc[2][2][4][2];
#pragma unroll
    for (int a = 0; a < 2; ++a)
#pragma unroll
        for (int b = 0; b < 2; ++b)
#pragma unroll
            for (int m = 0; m < 4; ++m)
#pragma unroll
                for (int n = 0; n < 2; ++n) acc[a][b][m][n] = (f32x4){0.f, 0.f, 0.f, 0.f};
    bf16x8 At[4][2], B0[2][2], B1[2][2];
    const char* cA = (const char*)g.A + (size_t)cur.pm * tstepA; const char* cB = (const char*)g.Bt + (size_t)cur.pn * tstepB;
    S.a_ready(cur);
    if constexpr (SP2) {
        PG8_STAGE(PG8_SB(0, 0), cB, voffB); PG8_STAGE(PG8_SB(0, 1), cB + hstepB, voffB); PG8_STAGE(PG8_SA(0, 0), cA, voffA); PG8_STAGE(PG8_SA(0, 1), cA + hstepA, voffA);
        if (wr == 1) PG8_BAR;
        PG8_WAIT_V(2); PG8_BAR;
        PG8_STAGE(PG8_SB(1, 0), cB + kstep, voffB); PG8_STAGE(PG8_SA(1, 0), cA + kstep, voffA); PG8_STAGE(PG8_SB(1, 1), cB + hstepB + kstep, voffB);
        PG8_WAIT_V(6); PG8_BAR;
    } else {
        PG8_STAGE(PG8_SB(0, 0), cB, voffB); PG8_STAGE(PG8_SA(0, 0), cA, voffA); PG8_STAGE(PG8_SB(0, 1), cB + hstepB, voffB); PG8_STAGE(PG8_SA(0, 1), cA + hstepA, voffA);
        if (wr == 1) PG8_BAR;
        PG8_WAIT_V(4); PG8_BAR;
        PG8_STAGE(PG8_SB(1, 0), cB + kstep, voffB); PG8_STAGE(PG8_SA(1, 0), cA + kstep, voffA); PG8_STAGE(PG8_SB(1, 1), cB + hstepB + kstep, voffB);
        PG8_WAIT_V(6); PG8_BAR;
    }
    for (;;) {
        const bool has_next = S.next(ui + 1, nxt);
        const char* nA = has_next ? (const char*)g.A + (size_t)nxt.pm * tstepA : cA; const char* nB = has_next ? (const char*)g.Bt + (size_t)nxt.pn * tstepB : cB;
        for (int t = 0; t < nt; t += 2) {
            const bool last = (t == nt - 2);
            const char* a1 = cA + (size_t)(t + 1) * kstep;
            const char* a2 = last ? nA : cA + (size_t)(t + 2) * kstep; const char* b2 = last ? nB : cB + (size_t)(t + 2) * kstep;
            const char* a3 = a2 + kstep; const char* b3 = b2 + kstep;
            if (last && has_next) S.a_ready(nxt);
            if constexpr (SP2) {
            PG8_LDB(B0, 0, 0); PG8_LDB(B1, 0, 1); PG8_SCHED; PG8_LDA(At, 0, 0); PG8_STAGE(PG8_SA(1, 1), a1 + hstepA, voffA);
            PG8_WAIT_V(8); PG8_WAIT_L(0); PG8_BAR; PG8_MMA(0, 0, At, B0); PG8_MMA(0, 1, At, B1); PG8_BAR; PG8_SCHED;
            PG8_LDA(At, 0, 1); PG8_STAGE(PG8_SB(0, 0), b2, voffB); PG8_STAGE(PG8_SB(0, 1), b2 + hstepB, voffB); PG8_STAGE(PG8_SA(0, 0), a2, voffA);
            PG8_WAIT_V(8); PG8_WAIT_L(0); PG8_BAR; PG8_MMA(1, 0, At, B0); PG8_MMA(1, 1, At, B1); PG8_BAR; PG8_SCHED;
            PG8_LDB(B0, 1, 0); PG8_LDB(B1, 1, 1); PG8_SCHED; PG8_LDA(At, 1, 0); PG8_STAGE(PG8_SA(0, 1), a2 + hstepA, voffA);
            PG8_WAIT_V(8); PG8_WAIT_L(0); PG8_BAR; PG8_MMA(0, 0, At, B0); PG8_MMA(0, 1, At, B1); PG8_BAR; PG8_SCHED;
            PG8_LDA(At, 1, 1); PG8_STAGE(PG8_SB(1, 0), b3, voffB); PG8_STAGE(PG8_SB(1, 1), b3 + hstepB, voffB); PG8_STAGE(PG8_SA(1, 0), a3, voffA);
            PG8_WAIT_V(8); PG8_WAIT_L(0); PG8_BAR; PG8_MMA(1, 0, At, B0); PG8_MMA(1, 1, At, B1); PG8_BAR; PG8_SCHED;
            } else {
            PG8_LDB(B0, 0, 0); PG8_SCHED; PG8_LDA(At, 0, 0); PG8_STAGE(PG8_SA(1, 1), a1 + hstepA, voffA);
            PG8_WAIT_L(8); PG8_BAR; PG8_WAIT_L(0); PG8_MMA(0, 0, At, B0); PG8_BAR; PG8_SCHED;
            PG8_LDB(B1, 0, 1); PG8_STAGE(PG8_SB(0, 0), b2, voffB);
            PG8_BAR; PG8_WAIT_L(0); PG8_MMA(0, 1, At, B1); PG8_BAR;
            PG8_LDA(At, 0, 1); PG8_STAGE(PG8_SA(0, 0), a2, voffA);
            PG8_BAR; PG8_WAIT_L(0); PG8_MMA(1, 0, At, B0); PG8_BAR; PG8_SCHED;
            PG8_STAGE(PG8_SB(0, 1), b2 + hstepB, voffB);
            PG8_WAIT_V(6); PG8_BAR; PG8_MMA(1, 1, At, B1); PG8_BAR;
            PG8_LDB(B0, 1, 0); PG8_SCHED; PG8_LDA(At, 1, 0); PG8_STAGE(PG8_SA(0, 1), a2 + hstepA, voffA);
            PG8_WAIT_L(8); PG8_BAR; PG8_WAIT_L(0); PG8_MMA(0, 0, At, B0); PG8_BAR; PG8_SCHED;
            PG8_LDB(B1, 1, 1); PG8_STAGE(PG8_SB(1, 0), b3, voffB);
            PG8_BAR; PG8_WAIT_L(0); PG8_MMA(0, 1, At, B1); PG8_BAR;
            PG8_LDA(At, 1, 1); PG8_STAGE(PG8_SA(1, 0), a3, voffA);
            PG8_BAR; PG8_WAIT_L(0); PG8_MMA(1, 0, At, B0); PG8_BAR; PG8_SCHED;
            PG8_STAGE(PG8_SB(1, 1), b3 + hstepB, voffB);
            PG8_WAIT_V(6); PG8_BAR; PG8_MMA(1, 1, At, B1); PG8_BAR;
            }
        }
        if constexpr (ALIGN_EPI) { if (wr == 0) PG8_BAR; }
        if constexpr (!Epi::AFTER_DRAIN) { E(acc, cur, wr, wc, fr, fq); S.done(cur); }
        if (!has_next) break;
#pragma unroll
        for (int a = 0; a < 2; ++a)
#pragma unroll
            for (int b = 0; b < 2; ++b)
#pragma unroll
                for (int m = 0; m < 4; ++m)
#pragma unroll
                    for (int n = 0; n < 2; ++n) acc[a][b][m][n] = (f32x4){0.f, 0.f, 0.f, 0.f};
        cur = nxt; cA = nA; cB = nB; ++ui;
        if constexpr (ALIGN_EPI) { if (wr == 1) PG8_BAR; }
    }
    PG8_WAIT_V(0);
    if constexpr (!ALIGN_EPI) { if (wr == 0) PG8_BAR; }
    PG8_BAR;
    if constexpr (Epi::AFTER_DRAIN) { E.fused(acc, cur, wr, wc, fr, fq, lds, wid, lane); S.done(cur); }
#undef PG8_SA
#undef PG8_SB
#undef PG8_STAGE
#undef PG8_LDA
#undef PG8_LDB
#undef PG8_MMA
#undef PG8_WAIT_V
#undef PG8_WAIT_L
#undef PG8_BAR
#undef PG8_SCHED
}
}

#include <hip/hip_bf16.h>
#include <cmath>
namespace attn_body {
using bf16=__hip_bfloat16;
using bf16x8=__attribute__((ext_vector_type(8)))short;
using s16x4=__attribute__((ext_vector_type(4)))short;
using f32x16=__attribute__((ext_vector_type(16)))float;
using u32x4=__attribute__((ext_vector_type(4)))unsigned;
constexpr int SEQ=4096,D=64,DM=3072,OP=1024;
constexpr int NW=8,QBLK=32,QB=QBLK*NW,KVBLK=64,NQB=SEQ/QB;
constexpr int ATTN_PITCH=DM, ATTN_UNIT_ROWS=QB;
__device__ __forceinline__ int crow(int r,int hi){return (r&3)+8*(r>>2)+4*hi;}
#define SBAR() __builtin_amdgcn_sched_barrier(0)
__device__ __forceinline__ void cmask(f32x16&p0,f32x16&p1,int jb,int qrel,int hi,int wq,float sl2){
  if(jb>wq){
    #pragma unroll
    for(int r=0;r<16;++r){p0[r]=-INFINITY;p1[r]=-INFINITY;}
  } else if(jb==wq){
    int kb=64*jb+4*hi-qrel; asm volatile("":"+v"(kb)); const float m2=-2.f*sl2;
    #pragma unroll
    for(int r=0;r<16;++r){const int d=kb+((r&3)+8*(r>>2)); const int d0=d>0?d:0; const int d1=(d+32)>0?(d+32):0; p0[r]=__builtin_fmaf(m2,(float)d0,p0[r]); p1[r]=__builtin_fmaf(m2,(float)d1,p1[r]);}
  }
}
constexpr int NSLOT=3, SLOTB=8192;
constexpr int LDS_K=0, LDS_V=NSLOT*SLOTB, LDS_WS=2*NSLOT*SLOTB, LDS_OST=LDS_WS+NW*64*4, LDS_BYTES=LDS_OST+NW*4096;
constexpr float C2=0.125f*1.4426950408889634f;
__device__ __forceinline__ void glds16(const void*gsrc,unsigned lds_dst){unsigned keep;
  asm volatile("s_mov_b32 %0, m0\n\ts_mov_b32 m0, %2\n\ts_nop 0\n\tglobal_load_lds_dwordx4 %1, off\n\ts_mov_b32 m0, %0":"=&s"(keep):"v"(gsrc),"s"(lds_dst):"memory");}
__device__ __forceinline__ float max3f(float a,float b,float c){float r;asm("v_max3_f32 %0, %1, %2, %3":"=v"(r):"v"(a),"v"(b),"v"(c));return r;}
__device__ __forceinline__ float max2f(float a,float b){float r;asm("v_max_f32_e32 %0, %1, %2":"=v"(r):"v"(a),"v"(b));return r;}
__device__ __forceinline__ float fadd_s(float a,float b){float r;asm("v_add_f32_e32 %0, %1, %2":"=v"(r):"v"(a),"v"(b));return r;}
__device__ __forceinline__ float fsub_s(float a,float b){float r;asm("v_sub_f32_e32 %0, %1, %2":"=v"(r):"v"(a),"v"(b));return r;}
typedef float f32x2_t __attribute__((ext_vector_type(2))); typedef __bf16 bf16x2_t __attribute__((ext_vector_type(2)));
__device__ __forceinline__ unsigned cvtpk_s(float lo,float hi){f32x2_t v={lo,hi};bf16x2_t b=__builtin_convertvector(v,bf16x2_t);return __builtin_bit_cast(unsigned,b);}
#define WAIT_BAR(N) asm volatile("s_waitcnt vmcnt(" #N ") lgkmcnt(0)\n\ts_barrier":::"memory")

__device__ __forceinline__ void qkt(f32x16&p0,f32x16&p1,const char*Kslot,const bf16x8*qr,const f32x16&negm,int r32,int hi){
  const char*kb=Kslot+r32*128; const int lp=((hi^(r32&7))<<4);
  #pragma unroll
  for(int d0=0;d0<4;++d0){
    const bf16x8 b0=*reinterpret_cast<const bf16x8*>(kb+(lp^(d0<<5)));
    const bf16x8 b1=*reinterpret_cast<const bf16x8*>(kb+(lp^(d0<<5))+4096);
    if(d0==0){p0=__builtin_amdgcn_mfma_f32_32x32x16_bf16(b0,qr[0],negm,0,0,0);p1=__builtin_amdgcn_mfma_f32_32x32x16_bf16(b1,qr[0],negm,0,0,0);}
    else{p0=__builtin_amdgcn_mfma_f32_32x32x16_bf16(b0,qr[d0],p0,0,0,0);p1=__builtin_amdgcn_mfma_f32_32x32x16_bf16(b1,qr[d0],p1,0,0,0);}}
}
typedef __attribute__((address_space(3))) const char* lds_cptr;
typedef short v4i16_t __attribute__((ext_vector_type(4)));
__device__ __forceinline__ void kload2(bf16x8*kf,lds_cptr kp,int j,int lp){ const lds_cptr a=kp+(lp^(j<<5)); kf[2*j]=*(const __attribute__((address_space(3))) bf16x8*)(a); kf[2*j+1]=*(const __attribute__((address_space(3))) bf16x8*)(a+4096); }
__device__ __forceinline__ void kload8(bf16x8*kf,lds_cptr kp,int lp){ kload2(kf,kp,0,lp); kload2(kf,kp,1,lp); kload2(kf,kp,2,lp); kload2(kf,kp,3,lp); }
__device__ __forceinline__ s16x4 vtr(lds_cptr p){ return __builtin_bit_cast(s16x4,__builtin_amdgcn_ds_read_tr16_b64_v4i16((__attribute__((address_space(3))) v4i16_t*)p)); }
__device__ __forceinline__ float rowmax(const f32x16&p0,const f32x16&p1){
  float a=max3f(p0[0],p0[1],p1[0]),b=max3f(p0[2],p0[3],p1[1]);a=max3f(a,p1[2],p1[3]);
  #pragma unroll
  for(int r=4;r<16;r+=4){a=max3f(a,p0[r],p0[r+1]);b=max3f(b,p0[r+2],p0[r+3]);a=max3f(a,p1[r],p1[r+1]);b=max3f(b,p1[r+2],p1[r+3]);}
  const float m=max2f(a,b);
  auto rr=__builtin_amdgcn_permlane32_swap(__float_as_uint(m),__float_as_uint(m),false,false);
  return max2f(__uint_as_float(rr[0]),__uint_as_float(rr[1]));
}
__device__ __forceinline__ void pv(f32x16*o,int vb,bf16x8 pa0,bf16x8 pa1,bf16x8 pa2,bf16x8 pa3){
  #pragma unroll
  for(int d0=0;d0<2;++d0){s16x4 lo[4],hi[4];
    #pragma unroll
    for(int ks=0;ks<4;++ks){
      asm volatile("ds_read_b64_tr_b16 %0,%1 offset:%c2":"=&v"(lo[ks]):"v"(vb),"i"(d0*4096+ks*1024):"memory");
      asm volatile("ds_read_b64_tr_b16 %0,%1 offset:%c2":"=&v"(hi[ks]):"v"(vb),"i"(d0*4096+ks*1024+512):"memory");}
    asm volatile("s_waitcnt lgkmcnt(0)":::"memory");SBAR();
    #define PK(k) (bf16x8){lo[k][0],lo[k][1],lo[k][2],lo[k][3],hi[k][0],hi[k][1],hi[k][2],hi[k][3]}
    o[d0]=__builtin_amdgcn_mfma_f32_32x32x16_bf16(pa0,PK(0),o[d0],0,0,0);
    o[d0]=__builtin_amdgcn_mfma_f32_32x32x16_bf16(pa1,PK(1),o[d0],0,0,0);
    o[d0]=__builtin_amdgcn_mfma_f32_32x32x16_bf16(pa2,PK(2),o[d0],0,0,0);
    o[d0]=__builtin_amdgcn_mfma_f32_32x32x16_bf16(pa3,PK(3),o[d0],0,0,0);
    #undef PK
  }
}

#ifndef ATTN_STORE16
#define ATTN_STORE16(p,v) (*(u32x4*)(p)=(v))
#endif
template<int THRL> __device__ __forceinline__ void attn_unit(int b,int qoff,int koff,int voff,int ooff,int hh,int qb,const bf16*PJ,bf16*O,char*shm,const int tid_in){
  const int tid=tid_in,lane=tid&63,r32=lane&31,hi=lane>>5; const int wid=__builtin_amdgcn_readfirstlane(tid>>6);
  const long rowbase=(long)b*SEQ; const int q0=qb*QB;
  const bf16*Qw=PJ+(rowbase+q0+wid*QBLK)*DM+qoff;
  const bf16*Kh=PJ+rowbase*DM+koff,*Vh=PJ+rowbase*DM+voff; const unsigned e_=(unsigned)(2*(hh+1))<<23; const float sl2=__builtin_bit_cast(float,0x3fb8aa3bu-e_), s2_=__builtin_bit_cast(float,0x3fb8aa3bu+(1u<<23)-e_), s3_=__builtin_bit_cast(float,0x408a7facu-e_), s8=__builtin_bit_cast(float,0x3fb8aa3bu+(3u<<23)-e_), s32_=__builtin_bit_cast(float,0x3fb8aa3bu+(5u<<23)-e_); const float hb=sl2*(float)(4*hi); const int wq=wid>>1; const f32x2_t c01={0.f,sl2},c23={s2_,s3_},c32={s32_,s32_};
  const unsigned lds0=(unsigned)(uintptr_t)shm;
  float*wsf=(float*)(shm+LDS_WS)+wid*64;
  const bf16*ksrc=Kh+(long)(8*wid+(lane>>3))*DM+(((lane&7)^(lane>>3))*8); const int lp=((hi^(r32&7))<<4);
  const bf16*vsrc=Vh+(long)(16*(wid&3)+(lane>>2))*DM+(wid>>2)*32+(lane&3)*8;
  const unsigned kdst=lds0+LDS_K+wid*1024, vdst=lds0+LDS_V+wid*1024;
  #define DMA_K(t,slot) glds16(ksrc+(long)(t)*KVBLK*DM,(unsigned)__builtin_amdgcn_readfirstlane(kdst+(slot)))
  #define DMA_V(t,slot) glds16(vsrc+(long)(t)*KVBLK*DM,(unsigned)__builtin_amdgcn_readfirstlane(vdst+(slot)))
  const int vb0=(int)(lds0+LDS_V)+((lane>>4)&1)*32+(lane&3)*8+(4*hi+((lane&15)>>2))*64;
  const char*Kbase=shm+LDS_K; bf16x8 kf[8];
  const lds_cptr shm3=(lds_cptr)shm; const lds_cptr kp0=shm3+LDS_K+r32*128; const lds_cptr vp0=shm3+LDS_V+((lane>>4)&1)*32+(lane&3)*8+(4*hi+((lane&15)>>2))*64;
  const int NT=(q0+QB)/KVBLK;
  DMA_K(0,0);DMA_V(0,0);DMA_K(1,SLOTB);
  bf16x8 qr[4];
  #pragma unroll
  for(int d0=0;d0<4;++d0)qr[d0]=*reinterpret_cast<const bf16x8*>(&Qw[(long)r32*DM+d0*16+hi*8]);
  float mhat=0.f,l_reg=0.f;f32x16 o[2];o[0]=f32x16{};o[1]=f32x16{};const f32x16 negm=f32x16{};
  const int qrel=wid*QBLK+r32;
  #define BIAS(P0,P1,t) do{ float tg_=hb-mhat; asm volatile("":"+v"(tg_)); tg_+=sl2*(float)(64*(t)); _Pragma("unroll") for(int g=0;g<4;++g){ const f32x2_t t2_={tg_,tg_}; const f32x2_t a_=t2_+c01, b_=t2_+c23, c_=a_+c32, d_=b_+c32; P0[4*g]+=a_.x; P0[4*g+1]+=a_.y; P0[4*g+2]+=b_.x; P0[4*g+3]+=b_.y; P1[4*g]+=c_.x; P1[4*g+1]+=c_.y; P1[4*g+2]+=d_.x; P1[4*g+3]+=d_.y; tg_+=s8; } }while(0)
  #define CMASK(P0,P1,t) do{int jb_=(t)-(NT-4); if(jb_>=0)cmask(P0,P1,jb_,qrel,hi,wq,sl2);}while(0)
  bool resc=false;
  #define START(P0,P1) do{ const float rm=rowmax(P0,P1); resc=false; \
    { const float dl=rm; mhat=fadd_s(mhat,dl); \
      _Pragma("unroll") for(int r=0;r<16;++r){P0[r]=fsub_s(P0[r],dl);P1[r]=fsub_s(P1[r],dl);} \
      } \
    _Pragma("unroll") for(int r=0;r<16;++r)P0[r]=__builtin_amdgcn_exp2f(P0[r]); }while(0)
  #define RESC() do{ if(resc){ asm volatile("s_waitcnt lgkmcnt(0)":::"memory"); \
      _Pragma("unroll") for(int d_=0;d_<2;++d_) _Pragma("unroll") for(int r=0;r<16;++r)o[d_][r]*=wsf[crow(r,hi)]; } }while(0)
  f32x16 pA0,pA1,pB0,pB1;
  int sl_prev=0,sl_cur=0,sl_next=SLOTB;
  #define ROT() do{sl_prev=sl_cur;sl_cur=sl_next;sl_next=(sl_next==(NSLOT-1)*SLOTB)?0:sl_next+SLOTB;}while(0)
  DMA_K(2,2*SLOTB);
  WAIT_BAR(3);
  qkt(pA0,pA1,Kbase,qr,negm,r32,hi);asm volatile("s_nop 15\n\ts_nop 7":"+v"(pA0),"+v"(pA1));BIAS(pA0,pA1,0);CMASK(pA0,pA1,0);
  START(pA0,pA1);
  _Pragma("unroll") for(int r=0;r<16;++r)pA1[r]=__builtin_amdgcn_exp2f(pA1[r]);
  WAIT_BAR(0);
  DMA_K(3,0);DMA_V(1,SLOTB);
  ROT();
  kload8(kf,kp0+sl_cur,lp);
  WAIT_BAR(2);
  s16x4 vlo[8],vhi[8]; u32x4 pw0,pw1,pw2,pw3;
  #define PKW(P,B) cvtpk_s(P[B],P[B+1])
  #define PAF(k) __builtin_bit_cast(bf16x8,pw##k)
  #define VFR(i) (bf16x8){vlo[i][0],vlo[i][1],vlo[i][2],vlo[i][3],vhi[i][0],vhi[i][1],vhi[i][2],vhi[i][3]}
  #define PIN(x) asm volatile("":"+v"(x))
  #define MX3(a,b,c) __builtin_fmaxf(__builtin_fmaxf((a),(b)),(c))
  #define GAPA(MF,A0,A1,A2,A3,W0,W1,PW) do{ MF; sacc+=A0; sacc+=A1; sacc+=A2; sacc+=A3; PIN(sacc); W0; W1; PIN(PW); SBAR(); }while(0)
  #define EX(v) __builtin_amdgcn_exp2f(v)
  #define GAPB(MF,X,B) do{ MF; X[B]=EX(X[B]); X[B+1]=EX(X[B+1]); X[B+2]=EX(X[B+2]); X[B+3]=EX(X[B+3]); PIN(X); SBAR(); }while(0)
  #define VRD(i) do{ vlo[i]=vtr(vp_+(((i)>>2)*4096+((i)&3)*1024)); vhi[i]=vtr(vp_+(((i)>>2)*4096+((i)&3)*1024+512)); }while(0)
  #define KRD(G,j) do{ if(G){ kload2(kf,kp0+sl_next,j,lp); SBAR(); } }while(0)
  #define STEP(C0,C1,P0,P1,t,GK,GV,GL) do{ SBAR(); \
    const lds_cptr vp_=vp0+sl_prev; \
    VRD(0); SBAR(); float sacc=(P0[0]+P0[1]); \
    GAPA(C0=__builtin_amdgcn_mfma_f32_32x32x16_bf16(kf[0],qr[0],negm,0,0,0), P0[2],P0[3],P0[4],P0[5],     pw0[0]=PKW(P0,0), pw0[1]=PKW(P0,2), pw0); \
    VRD(4); SBAR(); GAPA(C1=__builtin_amdgcn_mfma_f32_32x32x16_bf16(kf[1],qr[0],negm,0,0,0), P0[6],P0[7],P0[8],P0[9],     pw0[2]=PKW(P0,4), pw0[3]=PKW(P0,6), pw0); \
    VRD(1); SBAR(); GAPA(C0=__builtin_amdgcn_mfma_f32_32x32x16_bf16(kf[2],qr[1],C0,0,0,0),   P0[10],P0[11],P0[12],P0[13], pw1[0]=PKW(P0,8), pw1[1]=PKW(P0,10), pw1); \
    VRD(5); SBAR(); GAPA(C1=__builtin_amdgcn_mfma_f32_32x32x16_bf16(kf[3],qr[1],C1,0,0,0),   P0[14],P0[15],P1[0],P1[1],   pw1[2]=PKW(P0,12),pw1[3]=PKW(P0,14), pw1); \
    VRD(2); SBAR(); GAPA(C0=__builtin_amdgcn_mfma_f32_32x32x16_bf16(kf[4],qr[2],C0,0,0,0),   P1[2],P1[3],P1[4],P1[5],     pw2[0]=PKW(P1,0), pw2[1]=PKW(P1,2), pw2); \
    VRD(6); SBAR(); GAPA(C1=__builtin_amdgcn_mfma_f32_32x32x16_bf16(kf[5],qr[2],C1,0,0,0),   P1[6],P1[7],P1[8],P1[9],     pw2[2]=PKW(P1,4), pw2[3]=PKW(P1,6), pw2); \
    VRD(3); SBAR(); GAPA(C0=__builtin_amdgcn_mfma_f32_32x32x16_bf16(kf[6],qr[3],C0,0,0,0),   P1[10],P1[11],P1[12],P1[13], pw3[0]=PKW(P1,8), pw3[1]=PKW(P1,10), pw3); \
    VRD(7); SBAR(); GAPA(C1=__builtin_amdgcn_mfma_f32_32x32x16_bf16(kf[7],qr[3],C1,0,0,0),   P1[14],P1[15],0.f,0.f,       pw3[2]=PKW(P1,12),pw3[3]=PKW(P1,14), pw3); \
    l_reg+=sacc; \
    if(GK){DMA_K((t)+3,sl_cur);} if(GV){DMA_V((t)+1,sl_next);} \
    BIAS(C0,C1,t); CMASK(C0,C1,t); \
    { float a=MX3(C0[0],C0[1],C1[0]),b=MX3(C0[2],C0[3],C1[1]); a=MX3(a,C1[2],C1[3]); \
      _Pragma("unroll") for(int r=4;r<16;r+=4){a=MX3(a,C0[r],C0[r+1]);b=MX3(b,C0[r+2],C0[r+3]);a=MX3(a,C1[r],C1[r+1]);b=MX3(b,C1[r+2],C1[r+3]);} \
      float rm=__builtin_fmaxf(a,b); { auto rr=__builtin_amdgcn_permlane32_swap(__float_as_uint(rm),__float_as_uint(rm),false,false); rm=__builtin_fmaxf(__uint_as_float(rr[0]),__uint_as_float(rr[1])); } \
      resc=false; \
      if(__builtin_expect(__any(rm>(float)THRL),0)){ const float dl=__builtin_fmaxf(rm,0.f); mhat+=dl; \
        _Pragma("unroll") for(int r=0;r<16;++r){C0[r]-=dl;C1[r]-=dl;} \
        const float f=__builtin_amdgcn_exp2f(-dl); l_reg*=f; if(hi==0)wsf[r32]=f; resc=true; } } \
    SBAR(); \
    GAPB(o[0]=__builtin_amdgcn_mfma_f32_32x32x16_bf16(PAF(0),VFR(0),o[0],0,0,0), C0,0); \
    GAPB(o[1]=__builtin_amdgcn_mfma_f32_32x32x16_bf16(PAF(0),VFR(4),o[1],0,0,0), C0,4); \
    KRD(GL,0); GAPB(o[0]=__builtin_amdgcn_mfma_f32_32x32x16_bf16(PAF(1),VFR(1),o[0],0,0,0), C0,8); \
    KRD(GL,1); GAPB(o[1]=__builtin_amdgcn_mfma_f32_32x32x16_bf16(PAF(1),VFR(5),o[1],0,0,0), C0,12); \
    KRD(GL,2); GAPB(o[0]=__builtin_amdgcn_mfma_f32_32x32x16_bf16(PAF(2),VFR(2),o[0],0,0,0), C1,0); \
    KRD(GL,3); GAPB(o[1]=__builtin_amdgcn_mfma_f32_32x32x16_bf16(PAF(2),VFR(6),o[1],0,0,0), C1,4); \
    GAPB(o[0]=__builtin_amdgcn_mfma_f32_32x32x16_bf16(PAF(3),VFR(3),o[0],0,0,0), C1,8); \
    GAPB(o[1]=__builtin_amdgcn_mfma_f32_32x32x16_bf16(PAF(3),VFR(7),o[1],0,0,0), C1,12); \
    }while(0)
  int t=1;
  #undef CMASK
  #define CMASK(P0,P1,t) do{}while(0)
  for(;t+5<NT;t+=2){
    STEP(pB0,pB1,pA0,pA1,t,true,true,true);     WAIT_BAR(2); RESC(); ROT();
    STEP(pA0,pA1,pB0,pB1,t+1,true,true,true);   WAIT_BAR(2); RESC(); ROT();
  }
  #undef CMASK
  #define CMASK(P0,P1,t) do{int jb_=(t)-(NT-4); if(jb_>=0)cmask(P0,P1,jb_,qrel,hi,wq,sl2);}while(0)
  #define ENDW(tt) do{ if((tt)+3<NT){WAIT_BAR(2);} else if((tt)+2<NT){WAIT_BAR(1);} else {WAIT_BAR(0);} }while(0)
  for(;t+1<NT;t+=2){
    STEP(pB0,pB1,pA0,pA1,t,(t+3<NT),(t+1<NT),(t+1<NT));       ENDW(t);   RESC(); ROT();
    STEP(pA0,pA1,pB0,pB1,t+1,(t+4<NT),(t+2<NT),(t+2<NT));     ENDW(t+1); RESC(); ROT();
  }
  STEP(pB0,pB1,pA0,pA1,NT-1,false,false,false); RESC();
  { float sacc=pB0[0]+pB0[1]; _Pragma("unroll") for(int r=2;r<16;++r)sacc+=pB0[r]; _Pragma("unroll") for(int r=0;r<16;++r)sacc+=pB1[r]; l_reg+=sacc;
    pw0=(u32x4){PKW(pB0,0),PKW(pB0,2),PKW(pB0,4),PKW(pB0,6)};pw1=(u32x4){PKW(pB0,8),PKW(pB0,10),PKW(pB0,12),PKW(pB0,14)};pw2=(u32x4){PKW(pB1,0),PKW(pB1,2),PKW(pB1,4),PKW(pB1,6)};pw3=(u32x4){PKW(pB1,8),PKW(pB1,10),PKW(pB1,12),PKW(pB1,14)};
    SBAR(); pv(o,vb0+sl_cur,PAF(0),PAF(1),PAF(2),PAF(3)); }
  #undef PKW
  #undef PAF
  #undef VFR
  #undef PIN
  #undef MX3
  #undef GAPA
  #undef GAPB
  #undef EX
  #undef VRD
  #undef KRD
  #undef STEP
  #undef ENDW
  {auto rr=__builtin_amdgcn_permlane32_swap(__float_as_uint(l_reg),__float_as_uint(l_reg),false,false);l_reg=__uint_as_float(rr[0])+__uint_as_float(rr[1]);}
  if(hi==0)wsf[32+r32]=l_reg;asm volatile("s_waitcnt lgkmcnt(0)":::"memory");
  float rli[16];
  #pragma unroll
  for(int r=0;r<16;++r)rli[r]=__builtin_amdgcn_rcpf(wsf[32+crow(r,hi)]);
  bf16*Ow=O+(rowbase+q0+wid*QBLK)*OP+ooff;
  { bf16*stg=(bf16*)(shm+LDS_OST)+wid*2048;
    #pragma unroll
    for(int r=0;r<16;++r){const int orow=crow(r,hi);
      #pragma unroll
      for(int d0=0;d0<2;++d0)stg[orow*64+d0*32+r32]=__float2bfloat16(o[d0][r]*rli[r]);}
    asm volatile("s_waitcnt lgkmcnt(0)":::"memory");
    #pragma unroll
    for(int i=0;i<4;++i){const int row=i*8+(lane>>3),ch=lane&7; const u32x4 v=*(const u32x4*)(stg+row*64+ch*8); ATTN_STORE16(Ow+(long)row*OP+ch*8,v);} }
  asm volatile("s_waitcnt lgkmcnt(0)\n\ts_barrier":::"memory");
  #undef BIAS
  #undef DMA_K
  #undef DMA_V
  #undef CMASK
  #undef START
  #undef RESC
  #undef ROT
}
constexpr int ATTN_LDS_BYTES=LDS_BYTES;
#undef SBAR
#undef WAIT_BAR
}

namespace cg = cooperative_groups;
#define LAS __attribute__((address_space(3)))
typedef unsigned short bf16;
typedef unsigned v4u __attribute__((ext_vector_type(4)));
typedef unsigned v2u __attribute__((ext_vector_type(2)));
typedef float f32x4 __attribute__((ext_vector_type(4)));
typedef float f32x16v __attribute__((ext_vector_type(16)));
typedef short bf16x8 __attribute__((ext_vector_type(8)));
#define LDS_WAIT() asm volatile("s_waitcnt lgkmcnt(0)" ::: "memory")
#define VM_WAIT() asm volatile("s_waitcnt vmcnt(0)" ::: "memory")

constexpr int BATCH = 8, SEQ = 4096, DMODEL = 1024, M = BATCH * SEQ, INW = 3072, FF = 2816, FF2 = 5632, NMOD = 6 * DMODEL;
constexpr float RMS_EPS = 1e-6f;
constexpr float LOG2E = 1.4426950408889634f;
constexpr int C_DAQ = 0, C_DAK = 512, C_DAV = 1024, C_RQ = 1536, C_RK = 1792, C_RV = 2048, C_RG = 2560;
constexpr size_t MiB = 1u << 20;
constexpr size_t WS_CTL = 0, CTL_ZERO_BYTES = 16384;
constexpr size_t WS_MOD = CTL_ZERO_BYTES;
constexpr size_t WS_WIN = 2 * MiB, WS_WOUT = 8 * MiB, WS_WUP = 10 * MiB, WS_WDN = 21 * MiB;
constexpr size_t WS_PROJ = 32 * MiB;
constexpr size_t WS_OTMP = 224 * MiB;
constexpr size_t WS_MIX = 288 * MiB;
constexpr size_t WS_Y = 352 * MiB;
constexpr size_t WS_XN = 448 * MiB;
constexpr size_t WS_A2 = 32 * MiB;
constexpr size_t WS_RAWF = 384 * MiB, WS_RAWL = 390 * MiB;
constexpr size_t WS_X1B = 224 * MiB;
constexpr size_t WS_F = 400 * MiB;
constexpr size_t WS_END = 512 * MiB;
constexpr int LDS_BYTES = 147456;
constexpr int NWAVES = 8;

__device__ __forceinline__ unsigned f2bf(float f) { unsigned u = __builtin_bit_cast(unsigned, f); return (u + 0x7fffu + ((u >> 16) & 1u)) >> 16; }
__device__ __forceinline__ unsigned pk2(float lo, float hi) { return f2bf(lo) | (f2bf(hi) << 16); }
__device__ __forceinline__ float bflo(unsigned u) { return __builtin_bit_cast(float, u << 16); }
__device__ __forceinline__ float bfhi(unsigned u) { return __builtin_bit_cast(float, u & 0xffff0000u); }
__device__ __forceinline__ float wave_sum(float v) {
#pragma unroll
    for (int o = 1; o < 64; o <<= 1) v += __shfl_xor(v, o);
    return v;
}
__device__ __forceinline__ float silu_f(float v) { return v / (1.f + __expf(-v)); }

struct Args { const float* in[19]; float* out; unsigned char* ws; int ph_lo, ph_hi; };
enum { I_X = 0, I_C, I_WADA, I_BADA, I_GPREMIX, I_WIN, I_LQ1, I_LK1, I_LQ2, I_LK2, I_GSUB, I_WOUT, I_GPOSTMIX, I_GPREFFN, I_WUP, I_CONVW, I_CONVB, I_WDOWN, I_GPOSTFFN };

__device__ __forceinline__ void p0_transpose_item(const float* W, int K, int N, bf16* WT, LAS float* scr, int item, int lane, bool perm_up) {
    const int nblk = N / 32, kb = item / nblk, nb = item % nblk, k0 = 64 * kb, n0 = 32 * nb;
    const int orow0 = !perm_up ? n0 : (n0 < FF ? 256 * (n0 >> 7) + (n0 & 127) : 256 * ((n0 - FF) >> 7) + 128 + ((n0 - FF) & 127));
    float t_[32];
#pragma unroll
    for (int i = 0; i < 32; ++i) { const int kk = 2 * i + (lane >> 5); t_[i] = W[(size_t)(k0 + kk) * N + n0 + (lane & 31)]; }
#pragma unroll
    for (int i = 0; i < 32; ++i) { const int kk = 2 * i + (lane >> 5); scr[kk * 33 + (lane & 31)] = t_[i]; }
    LDS_WAIT(); asm volatile("" ::: "memory");
    const int c = lane & 7;
#pragma unroll
    for (int j = 0; j < 4; ++j) { const int n = (lane >> 3) + 8 * j; const LAS float* s = scr + (8 * c) * 33 + n;
        v4u o; o.x = pk2(s[0 * 33], s[1 * 33]); o.y = pk2(s[2 * 33], s[3 * 33]); o.z = pk2(s[4 * 33], s[5 * 33]); o.w = pk2(s[6 * 33], s[7 * 33]);
        *(v4u*)(WT + (size_t)(orow0 + n) * K + k0 + 8 * c) = o; }
    LDS_WAIT(); asm volatile("" ::: "memory");
}
__device__ __forceinline__ void p0_mod_item(const float* c, const float* wada, const float* bada, float* mod, LAS float* scr, int item, int lane) {
    const int nb = item % 96, kc = item / 96, n = nb * 64 + lane;
#pragma unroll
    for (int b = 0; b < 8; ++b) scr[lane * 8 + b] = silu_f(c[b * DMODEL + kc * 64 + lane]);
    LDS_WAIT(); asm volatile("" ::: "memory");
    float acc[8];
#pragma unroll
    for (int b = 0; b < 8; ++b) acc[b] = 0.f;
    const float* wp = wada + (size_t)(kc * 64) * NMOD + n;
#pragma unroll 1
    for (int k0 = 0; k0 < 64; k0 += 16) {
        float wv_[16];
#pragma unroll
        for (int q = 0; q < 16; ++q) wv_[q] = wp[(size_t)(k0 + q) * NMOD];
#pragma unroll
        for (int q = 0; q < 16; ++q) { const float w = wv_[q]; const int kk = k0 + q; const f32x4 s0 = *(const LAS f32x4*)(scr + kk * 8), s1 = *(const LAS f32x4*)(scr + kk * 8 + 4);
            acc[0] += s0[0] * w; acc[1] += s0[1] * w; acc[2] += s0[2] * w; acc[3] += s0[3] * w; acc[4] += s1[0] * w; acc[5] += s1[1] * w; acc[6] += s1[2] * w; acc[7] += s1[3] * w; }
    }
    const float bb = (kc == 0) ? bada[n] : 0.f;
#pragma unroll
    for (int b = 0; b < 8; ++b) atomicAdd(mod + b * NMOD + n, acc[b] + bb);
    LDS_WAIT(); asm volatile("" ::: "memory");
}
__device__ __forceinline__ float sumsq4(const f32x4 v) { return (v.x * v.x + v.y * v.y) + (v.z * v.z + v.w * v.w); }
__device__ __forceinline__ f32x4 unpk4(const v2u w) { return (f32x4){bflo(w.x), bfhi(w.x), bflo(w.y), bfhi(w.y)}; }
__device__ __forceinline__ void p1_rows(const float* x, const float* g, const float* mod, bf16* XN, int m0, int step, int lane) {
    f32x4 vn[4];
    if (m0 < M) {
#pragma unroll
        for (int j = 0; j < 4; ++j) vn[j] = ((const f32x4*)(x + (size_t)m0 * DMODEL))[lane + 64 * j]; }
    for (int m = m0; m < M; m += step) {
        f32x4 v[4]; float ss = 0.f;
#pragma unroll
        for (int j = 0; j < 4; ++j) { v[j] = vn[j]; ss += sumsq4(v[j]); }
        if (m + step < M) {
#pragma unroll
            for (int j = 0; j < 4; ++j) vn[j] = ((const f32x4*)(x + (size_t)(m + step) * DMODEL))[lane + 64 * j]; }
        const float* modb = mod + (m / SEQ) * NMOD;
        const float rstd = __builtin_amdgcn_rsqf(wave_sum(ss) * (1.f / DMODEL) + RMS_EPS);
        v2u* o8 = (v2u*)(XN + (size_t)m * DMODEL) + lane;
#pragma unroll
        for (int j = 0; j < 4; ++j) { const f32x4 g4 = ((const f32x4*)g)[lane + 64 * j], sh = ((const f32x4*)modb)[lane + 64 * j], sc = ((const f32x4*)(modb + DMODEL))[lane + 64 * j];
            const f32x4 o = v[j] * rstd * g4 * (sc + 1.f) + sh; v2u w; w.x = pk2(o.x, o.y); w.y = pk2(o.z, o.w); o8[64 * j] = w; }
    }
}
__device__ __forceinline__ void wave_sum2(float& a, float& b) {
#pragma unroll
    for (int o = 1; o < 64; o <<= 1) { const float ta = __shfl_xor(a, o), tb = __shfl_xor(b, o); a += ta; b += tb; }
}
__device__ __forceinline__ void p5_rows(const float* x, const bf16* Y, const float* gpm, const float* gpf, const float* mod, bf16* X1B, bf16* XN, int m0, int step, int lane) {
    f32x4 vn[2][4]; v2u yn[2][4];
#pragma unroll
    for (int r = 0; r < 2; ++r) { const int mr = m0 + r * step; if (mr < M) {
#pragma unroll
        for (int j = 0; j < 4; ++j) { vn[r][j] = ((const f32x4*)(x + (size_t)mr * DMODEL))[lane + 64 * j]; yn[r][j] = ((const v2u*)(Y + (size_t)mr * DMODEL))[lane + 64 * j]; } } }
    for (int m = m0; m < M; m += 2 * step) {
        f32x4 v[2][4], y[2][4]; float ss[2] = {0.f, 0.f};
        const bool has1 = (m + step) < M;
#pragma unroll
        for (int r = 0; r < 2; ++r)
#pragma unroll
            for (int j = 0; j < 4; ++j) { v[r][j] = vn[r][j]; y[r][j] = unpk4(yn[r][j]); ss[r] += sumsq4(y[r][j]); }
#pragma unroll
        for (int r = 0; r < 2; ++r) { const int mr = m + (2 + r) * step; if (mr < M) {
#pragma unroll
            for (int j = 0; j < 4; ++j) { vn[r][j] = ((const f32x4*)(x + (size_t)mr * DMODEL))[lane + 64 * j]; yn[r][j] = ((const v2u*)(Y + (size_t)mr * DMODEL))[lane + 64 * j]; } } }
        wave_sum2(ss[0], ss[1]);
        float s2[2] = {0.f, 0.f};
#pragma unroll
        for (int r = 0; r < 2; ++r) { if (r == 1 && !has1) break;
            const int mr = m + r * step; const float* modb = mod + (mr / SEQ) * NMOD;
            const float rstd = __builtin_amdgcn_rsqf(ss[r] * (1.f / DMODEL) + RMS_EPS);
#pragma unroll
            for (int j = 0; j < 4; ++j) { const f32x4 g4 = ((const f32x4*)gpm)[lane + 64 * j], gt = ((const f32x4*)(modb + 2 * DMODEL))[lane + 64 * j];
                v[r][j] = v[r][j] + gt * (y[r][j] * rstd * g4); { v2u w; w.x = pk2(v[r][j].x, v[r][j].y); w.y = pk2(v[r][j].z, v[r][j].w); ((v2u*)(X1B + (size_t)mr * DMODEL))[lane + 64 * j] = w; } s2[r] += sumsq4(v[r][j]); } }
        wave_sum2(s2[0], s2[1]);
#pragma unroll
        for (int r = 0; r < 2; ++r) { if (r == 1 && !has1) break;
            const int mr = m + r * step; const float* modb = mod + (mr / SEQ) * NMOD;
            const float rstd2 = __builtin_amdgcn_rsqf(s2[r] * (1.f / DMODEL) + RMS_EPS);
            v2u* o8 = (v2u*)(XN + (size_t)mr * DMODEL) + lane;
#pragma unroll
            for (int j = 0; j < 4; ++j) { const f32x4 g4 = ((const f32x4*)gpf)[lane + 64 * j], sh = ((const f32x4*)(modb + 3 * DMODEL))[lane + 64 * j], sc = ((const f32x4*)(modb + 4 * DMODEL))[lane + 64 * j];
                const f32x4 o = v[r][j] * rstd2 * g4 * (sc + 1.f) + sh; v2u w; w.x = pk2(o.x, o.y); w.y = pk2(o.z, o.w); o8[64 * j] = w; } }
    }
}
__device__ __forceinline__ void p9_rows(float* out, const bf16* X1B, const bf16* F, const float* gpost, const float* mod, int m0, int step, int lane) {
    v2u xn[4], yn[4];
    if (m0 < M) {
#pragma unroll
        for (int j = 0; j < 4; ++j) { xn[j] = ((const v2u*)(X1B + (size_t)m0 * DMODEL))[lane + 64 * j]; yn[j] = ((const v2u*)(F + (size_t)m0 * DMODEL))[lane + 64 * j]; } }
    for (int m = m0; m < M; m += step) {
        f32x4 v[4], y[4]; float ss = 0.f;
#pragma unroll
        for (int j = 0; j < 4; ++j) { v[j] = unpk4(xn[j]); y[j] = unpk4(yn[j]); ss += sumsq4(y[j]); }
        if (m + step < M) {
#pragma unroll
            for (int j = 0; j < 4; ++j) { xn[j] = ((const v2u*)(X1B + (size_t)(m + step) * DMODEL))[lane + 64 * j]; yn[j] = ((const v2u*)(F + (size_t)(m + step) * DMODEL))[lane + 64 * j]; } }
        const float* modb = mod + (m / SEQ) * NMOD;
        const float rstd = __builtin_amdgcn_rsqf(wave_sum(ss) * (1.f / DMODEL) + RMS_EPS);
        f32x4* xp = (f32x4*)(out + (size_t)m * DMODEL) + lane;
#pragma unroll
        for (int j = 0; j < 4; ++j) { const f32x4 g4 = ((const f32x4*)gpost)[lane + 64 * j], gt = ((const f32x4*)(modb + 5 * DMODEL))[lane + 64 * j];
            xp[64 * j] = v[j] + gt * (y[j] * rstd * g4); }
    }
}

__device__ __forceinline__ void unpack8(const v4u w, float (&f)[8]) { f[0] = bflo(w.x); f[1] = bfhi(w.x); f[2] = bflo(w.y); f[3] = bfhi(w.y); f[4] = bflo(w.z); f[5] = bfhi(w.z); f[6] = bflo(w.w); f[7] = bfhi(w.w); }
__device__ __forceinline__ void conv_fixup(int pm, const float* rawf, const float* rawl, const float* cw, const float* cb, bf16* A2, int tid) {
    const int R0 = pm * 256; if ((R0 & (SEQ - 1)) == 0) return;
    const float* l0 = rawl + ((size_t)(pm - 1) * 2 + 0) * FF2; const float* l1 = l0 + FF2; const float* f0 = rawf + ((size_t)pm * 2 + 0) * FF2; const float* f1 = f0 + FF2;
#pragma unroll 1
    for (int slot = tid; slot < FF / 4; slot += 512) {
        const int ch = 4 * slot, gi = 256 * (ch >> 7) + (ch & 127), vi = gi + 128;
        const f32x4 g2 = *(const f32x4*)(l0 + gi), g1 = *(const f32x4*)(l1 + gi), ga = *(const f32x4*)(f0 + gi), gb = *(const f32x4*)(f1 + gi);
        const f32x4 v2 = *(const f32x4*)(l0 + vi), v1 = *(const f32x4*)(l1 + vi), va = *(const f32x4*)(f0 + vi), vb = *(const f32x4*)(f1 + vi);
        const f32x4 w0g = *(const f32x4*)(cw + ch), w1g = *(const f32x4*)(cw + FF2 + ch), w2g = *(const f32x4*)(cw + 2 * FF2 + ch), bgv = *(const f32x4*)(cb + ch);
        const f32x4 w0v = *(const f32x4*)(cw + FF + ch), w1v = *(const f32x4*)(cw + FF2 + FF + ch), w2v = *(const f32x4*)(cw + 2 * FF2 + FF + ch), bvv = *(const f32x4*)(cb + FF + ch);
        const f32x4 cg0 = bgv + w0g * g2 + w1g * g1 + w2g * ga, cv0 = bvv + w0v * v2 + w1v * v1 + w2v * va;
        const f32x4 cg1 = bgv + w0g * g1 + w1g * ga + w2g * gb, cv1 = bvv + w0v * v1 + w1v * va + w2v * vb;
        v2u o0, o1; o0.x = pk2(silu_f(cg0.x) * cv0.x, silu_f(cg0.y) * cv0.y); o0.y = pk2(silu_f(cg0.z) * cv0.z, silu_f(cg0.w) * cv0.w);
        o1.x = pk2(silu_f(cg1.x) * cv1.x, silu_f(cg1.y) * cv1.y); o1.y = pk2(silu_f(cg1.z) * cv1.z, silu_f(cg1.w) * cv1.w);
        *(v2u*)(A2 + (size_t)R0 * FF + ch) = o0; *(v2u*)(A2 + (size_t)(R0 + 1) * FF + ch) = o1;
    }
}

__device__ __forceinline__ void da_combine(int b, int h, int qb, const bf16* OT, bf16* MIX, const float* gsub, float lam, int tid) {
    const size_t row = (size_t)b * SEQ + qb * 256 + (tid >> 1); const int half = tid & 1;
    const v4u* p1 = (const v4u*)(OT + row * DMODEL + (h * 4 + half) * 64);
    const v4u* p2 = (const v4u*)(OT + row * DMODEL + (h * 4 + 2 + half) * 64);
    float d[64]; float ss = 0.f;
#pragma unroll
    for (int j = 0; j < 8; ++j) { float a[8], c[8]; unpack8(p1[j], a); unpack8(p2[j], c);
#pragma unroll
        for (int e = 0; e < 8; ++e) { const float t = a[e] - lam * c[e]; d[8 * j + e] = t; ss += t * t; } }
    ss += __shfl_xor(ss, 1);
    const float rstd = __builtin_amdgcn_rsqf(ss * (1.f / 128.f) + RMS_EPS) * 0.8f;
    v4u* op = (v4u*)(MIX + row * DMODEL + h * 128 + half * 64);
#pragma unroll
    for (int j = 0; j < 8; ++j) { const f32x4 g0 = *(const f32x4*)(gsub + half * 64 + 8 * j), g1 = *(const f32x4*)(gsub + half * 64 + 8 * j + 4);
        v4u w; w.x = pk2(d[8 * j + 0] * rstd * g0[0], d[8 * j + 1] * rstd * g0[1]); w.y = pk2(d[8 * j + 2] * rstd * g0[2], d[8 * j + 3] * rstd * g0[3]);
        w.z = pk2(d[8 * j + 4] * rstd * g1[0], d[8 * j + 5] * rstd * g1[1]); w.w = pk2(d[8 * j + 6] * rstd * g1[2], d[8 * j + 7] * rstd * g1[3]); op[j] = w; }
}

namespace ret {
constexpr int LP = 72;
constexpr int OFF_Q = 0, OFF_K = OFF_Q + 64 * LP * 2, OFF_KT = OFF_K + 64 * LP * 2, OFF_VT = OFF_KT + 64 * LP * 2, OFF_ST = OFF_VT + 128 * LP * 2, OFF_P = OFF_ST + 128 * LP * 2, OFF_O = OFF_P + 64 * LP * 2;
constexpr int OP_F = 132;
constexpr int BYTES = OFF_O + 64 * OP_F * 4;
static_assert(BYTES <= 131072, "retention LDS");
__device__ __forceinline__ f32x16v mma64(f32x16v acc, const LAS bf16* A, int arow, const LAS bf16* B, int brow, int lane) {
    const int r = lane & 31, hi = lane >> 5;
#pragma unroll
    for (int ks = 0; ks < 4; ++ks) { const bf16x8 a = *(const LAS bf16x8*)(A + (arow + r) * LP + ks * 16 + hi * 8), b = *(const LAS bf16x8*)(B + (brow + r) * LP + ks * 16 + hi * 8);
        acc = __builtin_amdgcn_mfma_f32_32x32x16_bf16(a, b, acc, 0, 0, 0); }
    return acc;
}
__device__ __forceinline__ int crow(int r, int hi) { return (r & 3) + 8 * (r >> 2) + 4 * hi; }

template <int PITCH, int KS>
__device__ __forceinline__ f32x16v mmaT(f32x16v acc, const LAS bf16* A, int arow, const LAS bf16* B, int brow, int lane) {
    const int r = lane & 31, hi = lane >> 5;
#pragma unroll
    for (int ks = 0; ks < KS; ++ks) { const bf16x8 a = *(const LAS bf16x8*)(A + (arow + r) * PITCH + ks * 16 + hi * 8), b = *(const LAS bf16x8*)(B + (brow + r) * PITCH + ks * 16 + hi * 8);
        acc = __builtin_amdgcn_mfma_f32_32x32x16_bf16(a, b, acc, 0, 0, 0); }
    return acc;
}
constexpr int TP = 264;
static_assert((64 + 128) * TP * 2 <= BYTES, "pre-pass images alias the main buffers");
__device__ __forceinline__ void unit(int b, int h, int seg, const bf16* PJ, bf16* MIX, LAS unsigned char* lds, int tid) {
    const int lane = tid & 63, wid = __builtin_amdgcn_readfirstlane(tid >> 6), hi = lane >> 5, l31 = lane & 31;
    LAS bf16* Qc = (LAS bf16*)(lds + OFF_Q); LAS bf16* Kc = (LAS bf16*)(lds + OFF_K); LAS bf16* KT = (LAS bf16*)(lds + OFF_KT); LAS bf16* VT = (LAS bf16*)(lds + OFF_VT);
    LAS bf16* ST = (LAS bf16*)(lds + OFF_ST); LAS bf16* Pm = (LAS bf16*)(lds + OFF_P); LAS float* Of = (LAS float*)(lds + OFF_O);
    LAS bf16* KT4 = (LAS bf16*)lds; LAS bf16* VT4 = (LAS bf16*)(lds + 64 * TP * 2);
    const float lg2 = __builtin_amdgcn_logf(1.f - __builtin_amdgcn_exp2f(-5.f - (float)h));
    const float cdec = __builtin_amdgcn_exp2f(lg2 * 64.f);
    const int n_start = seg * 8, n_end = seg * 8 + 8;
    const size_t rowb = (size_t)b * SEQ;
    f32x16v Sacc = (f32x16v){};
    if (seg > 0) {
        const int tok0 = tid >> 2, ch0 = tid & 3;
        const float cdec4 = __builtin_amdgcn_exp2f(lg2 * 256.f);
        const float dj0 = 0.125f * __builtin_amdgcn_exp2f(lg2 * (float)(255 - tok0)), dj1 = 0.125f * __builtin_amdgcn_exp2f(lg2 * (float)(127 - tok0));
        v4u kx[4], vx[8];
        { const bf16* rp = PJ + (rowb + tok0) * INW;
#pragma unroll
          for (int p = 0; p < 4; ++p) kx[p] = *(const v4u*)(rp + (size_t)(128 * (p & 1)) * INW + C_RK + h * 64 + (ch0 + 4 * (p >> 1)) * 8);
#pragma unroll
          for (int p = 0; p < 8; ++p) vx[p] = *(const v4u*)(rp + (size_t)(128 * (p & 1)) * INW + C_RV + h * 128 + (ch0 + 4 * (p >> 1)) * 8); }
        const int nblk = 2 * seg;
        for (int blk = 0; blk < nblk; ++blk) {
#pragma unroll
            for (int p = 0; p < 4; ++p) { float kf[8]; unpack8(kx[p], kf); LAS bf16* dst = KT4 + ((ch0 + 4 * (p >> 1)) * 8) * TP + tok0 + 128 * (p & 1); const float dj = (p & 1) ? dj1 : dj0;
#pragma unroll
                for (int e = 0; e < 8; ++e) dst[e * TP] = (bf16)f2bf(kf[e] * dj); }
#pragma unroll
            for (int p = 0; p < 8; ++p) { const v4u w = vx[p]; LAS bf16* dst = VT4 + ((ch0 + 4 * (p >> 1)) * 8) * TP + tok0 + 128 * (p & 1);
                dst[0 * TP] = (bf16)(w.x & 0xffffu); dst[1 * TP] = (bf16)(w.x >> 16); dst[2 * TP] = (bf16)(w.y & 0xffffu); dst[3 * TP] = (bf16)(w.y >> 16);
                dst[4 * TP] = (bf16)(w.z & 0xffffu); dst[5 * TP] = (bf16)(w.z >> 16); dst[6 * TP] = (bf16)(w.w & 0xffffu); dst[7 * TP] = (bf16)(w.w >> 16); }
            if (blk + 1 < nblk) { const bf16* rp = PJ + (rowb + (size_t)(blk + 1) * 256 + tok0) * INW;
#pragma unroll
                for (int p = 0; p < 4; ++p) kx[p] = *(const v4u*)(rp + (size_t)(128 * (p & 1)) * INW + C_RK + h * 64 + (ch0 + 4 * (p >> 1)) * 8);
#pragma unroll
                for (int p = 0; p < 8; ++p) vx[p] = *(const v4u*)(rp + (size_t)(128 * (p & 1)) * INW + C_RV + h * 128 + (ch0 + 4 * (p >> 1)) * 8); }
            __syncthreads();
#pragma unroll
            for (int r = 0; r < 16; ++r) Sacc[r] *= cdec4;
            Sacc = mmaT<TP, 16>(Sacc, KT4, 32 * (wid >> 2), VT4, 32 * (wid & 3), lane);
            __syncthreads();
        }
        const int dv = 32 * (wid & 3) + l31;
#pragma unroll
        for (int g = 0; g < 4; ++g) { v2u w; w.x = pk2(Sacc[4 * g + 0], Sacc[4 * g + 1]); w.y = pk2(Sacc[4 * g + 2], Sacc[4 * g + 3]);
            *(LAS v2u*)(ST + dv * LP + 32 * (wid >> 2) + 8 * g + 4 * hi) = w; }
    } else {
        for (int i = tid; i < 128 * LP / 2; i += 512) ((LAS unsigned*)ST)[i] = 0u;
    }
    const int tj = tid & 63, tc = tid >> 6;
    v4u q8, k8, v8[2];
    { const bf16* rp = PJ + (rowb + (size_t)n_start * 64 + tj) * INW; k8 = *(const v4u*)(rp + C_RK + h * 64 + tc * 8); q8 = *(const v4u*)(rp + C_RQ + h * 64 + tc * 8);
#pragma unroll
      for (int i = 0; i < 2; ++i) { const int idx = tid + 512 * i; v8[i] = *(const v4u*)(PJ + (rowb + (size_t)n_start * 64 + (idx & 63)) * INW + C_RV + h * 128 + (idx >> 6) * 8); } }
    for (int c = n_start; c < n_end; ++c) {
        { float kf[8]; unpack8(k8, kf); const float dj = 0.125f * __builtin_amdgcn_exp2f(lg2 * (float)(63 - tj));
#pragma unroll
          for (int e = 0; e < 8; ++e) KT[(tc * 8 + e) * LP + tj] = (bf16)f2bf(kf[e] * dj);
          { v4u w; w.x = pk2(kf[0] * 0.125f, kf[1] * 0.125f); w.y = pk2(kf[2] * 0.125f, kf[3] * 0.125f); w.z = pk2(kf[4] * 0.125f, kf[5] * 0.125f); w.w = pk2(kf[6] * 0.125f, kf[7] * 0.125f);
              *(LAS v4u*)(Kc + tj * LP + tc * 8) = w; *(LAS v4u*)(Qc + tj * LP + tc * 8) = q8; }
#pragma unroll
          for (int i = 0; i < 2; ++i) { const int idx = tid + 512 * i, vj = idx & 63, vc = idx >> 6; const v4u w = v8[i];
              VT[(vc * 8 + 0) * LP + vj] = (bf16)(w.x & 0xffffu); VT[(vc * 8 + 1) * LP + vj] = (bf16)(w.x >> 16); VT[(vc * 8 + 2) * LP + vj] = (bf16)(w.y & 0xffffu); VT[(vc * 8 + 3) * LP + vj] = (bf16)(w.y >> 16);
              VT[(vc * 8 + 4) * LP + vj] = (bf16)(w.z & 0xffffu); VT[(vc * 8 + 5) * LP + vj] = (bf16)(w.z >> 16); VT[(vc * 8 + 6) * LP + vj] = (bf16)(w.w & 0xffffu); VT[(vc * 8 + 7) * LP + vj] = (bf16)(w.w >> 16); } }
        __syncthreads();
        const size_t row0 = rowb + (size_t)c * 64;
        if (c + 1 < n_end) {
            const bf16* rp = PJ + (row0 + 64 + tj) * INW; k8 = *(const v4u*)(rp + C_RK + h * 64 + tc * 8); q8 = *(const v4u*)(rp + C_RQ + h * 64 + tc * 8);
#pragma unroll
            for (int i = 0; i < 2; ++i) { const int idx = tid + 512 * i; v8[i] = *(const v4u*)(PJ + (row0 + 64 + (idx & 63)) * INW + C_RV + h * 128 + (idx >> 6) * 8); }
        }
        v4u gq[2];
        const int ni = tid >> 3, np = tid & 7;
        { const bf16* gp = PJ + (row0 + ni) * INW + C_RG + h * 128 + np * 16; gq[0] = *(const v4u*)gp; gq[1] = *(const v4u*)(gp + 8); }
        if (wid < 4) {
            const int ti = wid >> 1, tjj = wid & 1;
            f32x16v sc = mma64((f32x16v){}, Qc, 32 * ti, Kc, 32 * tjj, lane);
            const int j = 32 * tjj + l31;
#pragma unroll
            for (int r = 0; r < 16; ++r) { const int i = 32 * ti + crow(r, hi); const int dd = i > j ? i - j : j - i;
                Pm[i * LP + j] = (bf16)f2bf(sc[r] * __builtin_amdgcn_exp2f(lg2 * (float)dd)); }
        }
        __syncthreads();
        { const int ti = wid >> 2, tn = wid & 3;
          f32x16v a1 = mma64((f32x16v){}, Pm, 32 * ti, VT, 32 * tn, lane);
          f32x16v a2 = mma64((f32x16v){}, Qc, 32 * ti, ST, 32 * tn, lane);
#pragma unroll
          for (int r = 0; r < 16; ++r) { const int i = 32 * ti + crow(r, hi); Of[i * OP_F + 32 * tn + l31] = a1[r] + __builtin_amdgcn_exp2f(lg2 * (float)(i + 1)) * a2[r]; } }
#pragma unroll
        for (int r = 0; r < 16; ++r) Sacc[r] *= cdec;
        Sacc = mma64(Sacc, KT, 32 * (wid >> 2), VT, 32 * (wid & 3), lane);
        __syncthreads();
        if (c + 1 < n_end) {
            const int dv = 32 * (wid & 3) + l31;
#pragma unroll
            for (int g = 0; g < 4; ++g) { v2u w; w.x = pk2(Sacc[4 * g + 0], Sacc[4 * g + 1]); w.y = pk2(Sacc[4 * g + 2], Sacc[4 * g + 3]);
                *(LAS v2u*)(ST + dv * LP + 32 * (wid >> 2) + 8 * g + 4 * hi) = w; }
        }
        {
            float o[16]; float ss = 0.f;
#pragma unroll
            for (int q = 0; q < 4; ++q) { const f32x4 t = *(const LAS f32x4*)(Of + ni * OP_F + np * 16 + 4 * q); o[4 * q] = t.x; o[4 * q + 1] = t.y; o[4 * q + 2] = t.z; o[4 * q + 3] = t.w;
                ss += (t.x * t.x + t.y * t.y) + (t.z * t.z + t.w * t.w); }
            ss += __shfl_xor(ss, 1); ss += __shfl_xor(ss, 2); ss += __shfl_xor(ss, 4);
            const float rstd = __builtin_amdgcn_rsqf(ss * (1.f / 128.f) + RMS_EPS);
            float gf[16]; { float t0[8], t1[8]; unpack8(gq[0], t0); unpack8(gq[1], t1);
#pragma unroll
                for (int e = 0; e < 8; ++e) { gf[e] = t0[e]; gf[8 + e] = t1[e]; } }
#pragma unroll
            for (int e = 0; e < 16; ++e) o[e] = o[e] * rstd * silu_f(gf[e]);
            bf16* op = MIX + (row0 + ni) * DMODEL + 512 + h * 128 + np * 16;
            v4u w0, w1; w0.x = pk2(o[0], o[1]); w0.y = pk2(o[2], o[3]); w0.z = pk2(o[4], o[5]); w0.w = pk2(o[6], o[7]); w1.x = pk2(o[8], o[9]); w1.y = pk2(o[10], o[11]); w1.z = pk2(o[12], o[13]); w1.w = pk2(o[14], o[15]);
            *(v4u*)op = w0; *(v4u*)(op + 8) = w1;
        }
    }
    __syncthreads();
}
}

#define XB_TMO      128
#define XB_XCNT(j)  (256  + 64 * (j))
#define XB_XSUB(j)  (1280 + 64 * (j))
#define XB_XGEN(j)  (2304 + 64 * (j))
#define XB_TOP      3328
#define XB_TOPGEN   3392
#define XCD_BAR_WORDS 3456
#define XB_SPIN_CAP (1u << 18)

__device__ __forceinline__ unsigned xb_ld(unsigned* p)              { return __hip_atomic_load(p, __ATOMIC_RELAXED, __HIP_MEMORY_SCOPE_AGENT); }
__device__ __forceinline__ unsigned xb_add(unsigned* p, unsigned v) { return __hip_atomic_fetch_add(p, v, __ATOMIC_RELAXED, __HIP_MEMORY_SCOPE_AGENT); }
__device__ __forceinline__ unsigned xb_xcc_id() { return (unsigned)__builtin_amdgcn_s_getreg((3 << 11) | 20) & 0xFu; }
#define XB_SPIN(cond, bar) do { unsigned _sp = 0; while (cond) { __builtin_amdgcn_s_sleep(1); \
    if ((++_sp & 255u) == 0u) { if (xb_ld(&(bar)[XB_TMO])) break; if (_sp > XB_SPIN_CAP) { atomicAdd(&(bar)[XB_TMO], 1u); break; } } } } while (0)

struct XcdBarrier {
    unsigned* bar; unsigned x;
    volatile LAS unsigned* st;
};

__device__ __forceinline__ XcdBarrier xcd_barrier_post(unsigned* bar, volatile LAS unsigned* st) {
    XcdBarrier b; b.bar = bar; b.x = xb_xcc_id(); b.st = st;
    if (threadIdx.x == 0) (void)xb_add(&bar[XB_XCNT(b.x)], 1u);
    return b;
}
__device__ __forceinline__ void xcd_barrier_complete(unsigned* bar, unsigned x, unsigned& nloc, unsigned& nx) {
    const unsigned G = gridDim.x * gridDim.y * gridDim.z;
    unsigned sum, cnt, mine, sp = 0u;
    for (;;) {
        sum = 0u; cnt = 0u; mine = 0u;
#pragma unroll
        for (unsigned j = 0; j < 16; ++j) { const unsigned c = xb_ld(&bar[XB_XCNT(j)]); sum += c; cnt += (c > 0u) ? 1u : 0u; mine = (j == x) ? c : mine; }
        if (sum == G) break;
        __builtin_amdgcn_s_sleep(1);
        if ((++sp & 255u) == 0u) { if (xb_ld(&bar[XB_TMO])) break; if (sp > XB_SPIN_CAP) { atomicAdd(&bar[XB_TMO], 1u); break; } }
    }
    nloc = mine > 0u ? mine : 1u; nx = cnt > 0u ? cnt : 1u;
}

__device__ __forceinline__ void xcd_barrier(const XcdBarrier& b) {
    asm volatile("s_waitcnt vmcnt(0)" ::: "memory");
    __syncthreads();
    if (threadIdx.x == 0) {
        unsigned* bar = b.bar;
        __builtin_amdgcn_s_waitcnt(0);
        unsigned nloc = b.st[0], nx = b.st[1];
        if (nloc == 0u) { xcd_barrier_complete(bar, b.x, nloc, nx); b.st[0] = nloc; b.st[1] = nx; }
        const unsigned old = xb_add(&bar[XB_XSUB(b.x)], 1u);
        const unsigned gen = old / nloc;
        if (old + 1u == (gen + 1u) * nloc) {
            __builtin_amdgcn_fence(__ATOMIC_RELEASE, "agent");
            asm volatile("s_waitcnt vmcnt(0)" ::: "memory");
            const unsigned og = xb_add(&bar[XB_TOP], 1u);
            const unsigned tg = og / nx;
            if (og + 1u == (tg + 1u) * nx) xb_add(&bar[XB_TOPGEN], 1u);
            else XB_SPIN(xb_ld(&bar[XB_TOPGEN]) == tg, bar);
            __builtin_amdgcn_fence(__ATOMIC_ACQUIRE, "agent");
            xb_add(&bar[XB_XGEN(b.x)], 1u);
            asm volatile("s_waitcnt vmcnt(0)" ::: "memory");
        } else {
            XB_SPIN(xb_ld(&bar[XB_XGEN(b.x)]) == gen, bar);
            __builtin_amdgcn_fence(__ATOMIC_ACQUIRE, "agent");
            asm volatile("s_waitcnt vmcnt(0)" ::: "memory");
        }
    }
    __syncthreads();
}

__global__ void __launch_bounds__(NWAVES * 64, 2) fwd_kernel(Args args) {
    extern __shared__ __attribute__((aligned(16))) unsigned char lds[];
    { volatile LAS unsigned* st0 = (volatile LAS unsigned*)((LAS unsigned char*)lds + LDS_BYTES - 16); if (threadIdx.x < 4) st0[threadIdx.x] = 0u; }
    __syncthreads();
    if (args.ph_hi - args.ph_lo > 1) (void)xcd_barrier_post((unsigned*)(args.ws + WS_CTL), (volatile LAS unsigned*)((LAS unsigned char*)lds + LDS_BYTES - 16));
#define TID tl_
#define LANE (TID & 63)
#define WAVE (__builtin_amdgcn_readfirstlane(TID >> 6))
#define GRID gl_
#define BX bxl_
#define VCU ((GRID % 8 == 0) ? (BX % 8) * (GRID / 8) + BX / 8 : BX)
#define GW (VCU * NWAVES + WAVE)
#define NGW (GRID * NWAVES)
#define LDSP ((LAS unsigned char*)lds)
#define ARGIN(i) (((const float* const __attribute__((address_space(4)))*)kp_)[i])
#define ARGOUT (((float* const __attribute__((address_space(4)))*)kp_)[19])
#define WSP(off) ((bf16*)(wsl_ + (off)))
#define MODP ((float*)(wsl_ + WS_MOD))
#ifndef PHMASK
#define PHMASK 0x3ff
#endif
#define IN(k) (((PHMASK >> (k)) & 1) && args.ph_lo <= (k) && (k) < args.ph_hi)
#define SEAM(k) do { if (args.ph_lo <= (k) && (k) + 1 < args.ph_hi) { cg::this_grid().sync(); } } while (0)

  for (int ph = args.ph_lo; ph < args.ph_hi; ++ph) {
    if (ph == 7) continue;
    int tl_ = (int)threadIdx.x; asm volatile("" : "+v"(tl_));
    int bxl_ = (int)blockIdx.x; asm volatile("" : "+s"(bxl_));
    int gl_ = (int)gridDim.x; asm volatile("" : "+s"(gl_));
    const __attribute__((address_space(4))) unsigned char* kp_ = (const __attribute__((address_space(4))) unsigned char*)__builtin_amdgcn_kernarg_segment_ptr(); asm volatile("" : "+s"(kp_));
    unsigned char* wsl_ = ((unsigned char* const __attribute__((address_space(4)))*)kp_)[20];
    if (ph == 2 || ph == 4 || ph == 6 || ph == 8) {
        size_t oa = WS_XN, ob = WS_WIN, oc = WS_PROJ; int N = INW, K = DMODEL, lda = DMODEL, ldc = INW, scols = 512, mode = 0; float sc0 = 0.125f * LOG2E;
        if (ph == 4) { oa = WS_MIX; ob = WS_WOUT; oc = WS_Y; N = DMODEL; ldc = DMODEL; scols = 0; sc0 = 1.f; }
        if (ph == 6) { oa = WS_XN; ob = WS_WUP; oc = WS_A2; N = FF2; ldc = FF; scols = 0; sc0 = 1.f; mode = 1; }
        if (ph == 8) { oa = WS_A2; ob = WS_WDN; oc = WS_F; N = DMODEL; K = FF; lda = FF; ldc = DMODEL; scols = 0; sc0 = 1.f; }
        pg8::Gemm g{WSP(oa), WSP(ob), M, N, K, lda}; pg8::StaticOrder S; S.init(M, N, GRID, BX, (N == DMODEL) ? 8 : 4);
        if (ph == 8) {
            pg8::Unit u_;
            for (int i = 0; S.next(i, u_); ++i) conv_fixup(u_.pm, (const float*)(wsl_ + WS_RAWF), (const float*)(wsl_ + WS_RAWL), ARGIN(I_CONVW), ARGIN(I_CONVB), WSP(WS_A2), TID);
            VM_WAIT(); __syncthreads();
        }
        pg8::EpiBf16 E{WSP(oc), ldc, scols, sc0, mode, ARGIN(I_CONVW), ARGIN(I_CONVB), (float*)(wsl_ + WS_RAWF), (float*)(wsl_ + WS_RAWL), (LAS float*)(LDSP + 131072)};
        pg8::gemm_phase<pg8::EpiBf16, pg8::StaticOrder, true, true>(LDSP, g, S, E, TID);
    } else if (ph == 0) {
        const int lane = LANE, wave = WAVE, gw = GW, ngw = NGW;
        LAS float* scr = (LAS float*)(LDSP + wave * 16384);
        constexpr int T_IN = (DMODEL / 64) * (INW / 32), T_OUT = (DMODEL / 64) * (DMODEL / 32), T_UP = (DMODEL / 64) * (FF2 / 32), T_DN = (FF / 64) * (DMODEL / 32), T_MOD = 96 * 16;
        constexpr int NITEMS = T_IN + T_OUT + T_UP + T_DN + T_MOD;
        for (int it = gw; it < NITEMS; it += ngw) {
            int r = it;
            if (r < T_MOD) { p0_mod_item(ARGIN(I_C), ARGIN(I_WADA), ARGIN(I_BADA), MODP, scr, r, lane); continue; } r -= T_MOD;
            const float* W = ARGIN(I_WIN); int K = DMODEL, N = INW; size_t wo = WS_WIN; bool pu = false;
            if (r >= T_IN) { r -= T_IN; W = ARGIN(I_WOUT); N = DMODEL; wo = WS_WOUT;
                if (r >= T_OUT) { r -= T_OUT; W = ARGIN(I_WUP); N = FF2; wo = WS_WUP; pu = true;
                    if (r >= T_UP) { r -= T_UP; W = ARGIN(I_WDOWN); K = FF; N = DMODEL; wo = WS_WDN; pu = false; } } }
            p0_transpose_item(W, K, N, WSP(wo), scr, r, lane, pu);
        }
        if (BX == 0 && wave == 0) {
            const float a = ARGIN(I_LQ1)[lane] * ARGIN(I_LK1)[lane], b2 = ARGIN(I_LQ2)[lane] * ARGIN(I_LK2)[lane];
            const float sa = wave_sum(a), sb = wave_sum(b2);
            if (lane == 0) (MODP + 8 * NMOD)[0] = __expf(sa) - __expf(sb) + 0.2f;
        }
    } else if (ph == 1) {
        const int lane = LANE, ngw = NGW;
        p1_rows(ARGIN(I_X), ARGIN(I_GPREMIX), MODP, WSP(WS_XN), GW, ngw, lane);
    } else if (ph == 3) {
        for (int it = BX; it < 512; it += GRID) {
            const int slot = it & 255, rnd = it >> 8; const int xq = slot & 7, cq = slot >> 3;
            const int bh = 4 * xq + 2 * rnd + (cq >> 4), jq = cq & 15, b = bh >> 2, h = bh & 3;
            const int qb = (int)(((rnd == 0 ? 0x2170a6fedcb98543ull : 0xab6d480123579cefull) >> (4 * jq)) & 15ull);
#ifndef P3_NO_ATTN
#pragma unroll 1
            for (int sub = 0; sub < 4; ++sub) {
                const int mm = sub >> 1, vh = sub & 1;
                attn_body::attn_unit<100>(b, C_DAQ + h * 128 + mm * 64, C_DAK + h * 128 + mm * 64, C_DAV + h * 128 + vh * 64, (h * 4 + sub) * 64, h, qb,
                                        (const attn_body::bf16*)WSP(WS_PROJ), (attn_body::bf16*)WSP(WS_OTMP), (char*)lds, TID);
            }
#endif
            VM_WAIT(); __syncthreads();
#ifndef P3_NO_COMB
            { int tc_ = TID; asm volatile("" : "+v"(tc_)); da_combine(b, h, qb, WSP(WS_OTMP), WSP(WS_MIX), ARGIN(I_GSUB), (MODP + 8 * NMOD)[0], tc_); }
#endif
            __syncthreads();
        }
#ifndef P3_NO_RET
        for (int it = BX; it < 256; it += GRID) {
            const int xr = it & 7, cr = it >> 3, bhr = 4 * xr + 2 * (cr >> 4) + (cr & 1), segr = (cr & 15) >> 1;
            int tr_ = TID; asm volatile("" : "+v"(tr_));
            ret::unit(bhr >> 2, bhr & 3, segr, WSP(WS_PROJ), WSP(WS_MIX), LDSP, tr_);
        }
#endif
    } else if (ph == 5) {
        const int lane = LANE, ngw = NGW;
        p5_rows(ARGIN(I_X), WSP(WS_Y), ARGIN(I_GPOSTMIX), ARGIN(I_GPREFFN), MODP, WSP(WS_X1B), WSP(WS_XN), GW, ngw, lane);
    } else if (ph == 9) {
        const int lane = LANE, ngw = NGW;
        p9_rows(ARGOUT, WSP(WS_X1B), WSP(WS_F), ARGIN(I_GPOSTFFN), MODP, GW, ngw, lane);
    }
    if (ph + 1 < args.ph_hi) {
        if (args.ph_hi > 64) cg::this_grid().sync();
        else { XcdBarrier xb_; xb_.bar = (unsigned*)(wsl_ + WS_CTL); xb_.x = xb_xcc_id(); xb_.st = (volatile LAS unsigned*)((LAS unsigned char*)lds + LDS_BYTES - 16); xcd_barrier(xb_); }
    }
  }
#undef IN
#undef SEAM
}

extern "C" void kernel_launch(void* const* d_in, const int* in_sizes, int n_in, void* d_out, int out_size, void* d_ws, size_t ws_size, hipStream_t stream) {
    static int grid = 0;
    if (grid == 0) {
        if (n_in != 19 || in_sizes[0] != M * DMODEL || out_size != M * DMODEL || ws_size < WS_END) {
            fprintf(stderr, "kernel_launch: unexpected shapes: n_in %d in0 %d out %d ws %zu (need >= %zu)\n", n_in, n_in > 0 ? in_sizes[0] : -1, out_size, ws_size, (size_t)WS_END); grid = -1; return; }
        int dev = 0, cus = 0, per_cu = 0;
        hipGetDevice(&dev); hipDeviceGetAttribute(&cus, hipDeviceAttributeMultiprocessorCount, dev);
        if (hipFuncSetAttribute((const void*)fwd_kernel, hipFuncAttributeMaxDynamicSharedMemorySize, LDS_BYTES) != hipSuccess) fprintf(stderr, "kernel_launch: hipFuncSetAttribute failed\n");
        if (hipOccupancyMaxActiveBlocksPerMultiprocessor(&per_cu, (const void*)fwd_kernel, NWAVES * 64, LDS_BYTES) != hipSuccess || per_cu < 1) { fprintf(stderr, "kernel_launch: occupancy query gave %d\n", per_cu); per_cu = 1; }
        (void)hipGetLastError();
        grid = cus * (per_cu > 1 ? 1 : per_cu);
        if (grid <= 0) grid = 256;
    }
    if (grid < 0) return;
    hipMemsetAsync((char*)d_ws + WS_CTL, 0, CTL_ZERO_BYTES + (size_t)8 * NMOD * 4, stream);
    Args a{};
    for (int i = 0; i < 19; ++i) a.in[i] = (const float*)d_in[i];
    a.out = (float*)d_out; a.ws = (unsigned char*)d_ws;
#if MK_N_LAUNCHES == 1
    a.ph_lo = 0; a.ph_hi = 10;
    void* kargs[] = {&a};
    hipError_t e = hipLaunchCooperativeKernel((const void*)fwd_kernel, dim3(grid), dim3(NWAVES * 64), kargs, LDS_BYTES, stream);
    if (e != hipSuccess) fprintf(stderr, "cooperative launch failed: %s (grid %d)\n", hipGetErrorString(e), grid);
#else
    for (int p = 0; p < 10; ++p) { a.ph_lo = p; a.ph_hi = p + 1; hipLaunchKernelGGL(fwd_kernel, dim3(grid), dim3(NWAVES * 64), LDS_BYTES, stream, a); }
#endif
}
```

```cpp
#include <hip/hip_runtime.h>
#include <hip/hip_cooperative_groups.h>
#include <cstdio>
#include <cstdint>
#ifndef MK_N_LAUNCHES
#define MK_N_LAUNCHES 1
#endif
namespace pg8 {
#define PG8_LAS __attribute__((address_space(3)))
typedef unsigned short bf16_t;
typedef short bf16x8 __attribute__((ext_vector_type(8)));
typedef float f32x4 __attribute__((ext_vector_type(4)));
typedef unsigned u32x4 __attribute__((ext_vector_type(4)));
constexpr int BM = 256, BK = 64, HALF = 128, HTB = HALF * BK * 2  , STAGE_BYTES = 8 * HTB, NXCD = 8, WGM = 8;

__host__ __device__ __forceinline__ int lds_byte(int r, int c) { const int st = (r >> 4) * 2 + (c >> 5), rr = r & 15, cc = c & 31, ob = rr * 64 + cc * 2; return st * 1024 + (ob ^ (((ob >> 9) & 1) << 5)); }
__host__ __device__ __forceinline__ void stage_rc(int b, int& R, int& C) { const int st = b / 1024, sb = b % 1024, swz = sb ^ (((sb >> 9) & 1) << 5); R = (st >> 1) * 16 + swz / 64; C = (st & 1) * 32 + (swz % 64) / 2; }
__host__ __device__ __forceinline__ int perm32(int rho) { const int n = rho >> 4, i = rho & 15; return 8 * (i >> 2) + 4 * n + (i & 3); }

struct Unit { int pm, pn; };
struct Gemm { const bf16_t* A; const bf16_t* Bt; int M, N, K, lda; };

struct StaticOrder {
    int nM, nN, nwg, G, c, wgm;
    __host__ __device__ void init(int M, int N, int G_, int c_, int wgm_ = WGM) { nM = M / BM; nN = N / BM; nwg = nM * nN; G = G_; c = c_; wgm = wgm_; }
    __host__ __device__ bool next(int i, Unit& u) const {
        const long L = (long)i * G + c; if (L >= nwg) return false;
        int wgid = (int)L; { const int q = nwg / NXCD, r = nwg % NXCD, xcd = wgid % NXCD, off = wgid / NXCD; wgid = (xcd < r ? xcd * (q + 1) : r * (q + 1) + (xcd - r) * q) + off; }
        const int nig = wgm * nN, gid = wgid / nig, fm = gid * wgm, gsz = (nM - fm) < wgm ? (nM - fm) : wgm;
        u.pm = fm + ((wgid % nig) % gsz); u.pn = (wgid % nig) / gsz; return true;
    }
    __device__ __forceinline__ void a_ready(const Unit&) const {}
    __device__ __forceinline__ void done(const Unit&) const {}
};

__device__ __forceinline__ unsigned cvt_pk_bf16(float lo, float hi) { unsigned r; asm volatile("v_cvt_pk_bf16_f32 %0, %1, %2" : "=v"(r) : "v"(lo), "v"(hi)); return r; }

template <int CTRL> __device__ __forceinline__ float dpp_mov(float old, float src) {
    return __builtin_bit_cast(float, __builtin_amdgcn_update_dpp(__builtin_bit_cast(int, old), __builtin_bit_cast(int, src), CTRL, 0xf, 0xf, false)); }
__device__ __forceinline__ float silu_e(float v) { return v * __builtin_amdgcn_rcpf(1.f + __builtin_amdgcn_exp2f(-1.4426950408889634f * v)); }
typedef unsigned u32x2 __attribute__((ext_vector_type(2)));
struct EpiBf16 {
    static constexpr bool PERM = true, AFTER_DRAIN = false;
    bf16_t* O; int ldc; int scale_cols; float scale0; int mode; const float* cw; const float* cb; float* rawf; float* rawl; PG8_LAS float* xb;
    __device__ __forceinline__ void operator()(f32x4 (&acc)[2][2][4][2], const Unit& u, int wr, int wc, int fr, int fq) const {
      if (mode == 0) {
        const int row0 = u.pm * BM + wr * 64 + fr; const int colt = u.pn * BM;
        const float sc = (colt < scale_cols) ? scale0 : 1.f;
        const int col0 = colt + wc * 32 + 8 * fq;
#pragma unroll
        for (int ai = 0; ai < 2; ++ai)
#pragma unroll
            for (int m = 0; m < 4; ++m) { const int row = row0 + ai * HALF + m * 16; bf16_t* rowp = O + (size_t)row * ldc + col0;
#pragma unroll
                for (int bj = 0; bj < 2; ++bj) { f32x4 v0 = acc[ai][bj][m][0] * sc, v1 = acc[ai][bj][m][1] * sc;
                    u32x4 w; w.x = cvt_pk_bf16(v0[0], v0[1]); w.y = cvt_pk_bf16(v0[2], v0[3]); w.z = cvt_pk_bf16(v1[0], v1[1]); w.w = cvt_pk_bf16(v1[2], v1[3]);
                    *(u32x4*)(rowp + bj * HALF) = w; } }
      } else {
        const int R0 = u.pm * BM, colq = wc * 32 + 8 * fq, tcol = u.pn * BM; const bool bstart = (R0 & 4095) == 0;
        PG8_LAS f32x4* wt = (PG8_LAS f32x4*)(xb + 2048);
        f32x4 wld = (f32x4){0.f, 0.f, 0.f, 0.f};
        if (wr == 0) { const int pp = fr & 7, nn = fr >> 3, chn = u.pn * HALF + colq + 4 * nn;
            const float* src = (pp < 3) ? cw + pp * 5632 + chn : (pp == 3) ? cb + chn : (pp < 7) ? cw + (pp - 4) * 5632 + 2816 + chn : cb + 2816 + chn;
            wld = *(const f32x4*)src; }
        if (fr >= 14) {
#pragma unroll
            for (int ai = 0; ai < 2; ++ai)
#pragma unroll
                for (int bj = 0; bj < 2; ++bj)
#pragma unroll
                    for (int n = 0; n < 2; ++n) *(PG8_LAS f32x4*)(xb + ((ai * 2 + wr) * 2 + (fr - 14)) * 256 + bj * HALF + colq + 4 * n) = acc[ai][bj][3][n];
            if (wr == 1) {
#pragma unroll
                for (int bj = 0; bj < 2; ++bj)
#pragma unroll
                    for (int n = 0; n < 2; ++n) *(f32x4*)(rawl + ((size_t)u.pm * 2 + (fr - 14)) * 5632 + tcol + bj * HALF + colq + 4 * n) = acc[1][bj][3][n]; }
        }
        if (fr < 2 && wr == 0) {
#pragma unroll
            for (int bj = 0; bj < 2; ++bj)
#pragma unroll
                for (int n = 0; n < 2; ++n) *(f32x4*)(rawf + ((size_t)u.pm * 2 + fr) * 5632 + tcol + bj * HALF + colq + 4 * n) = acc[0][bj][0][n]; }
        if (wr == 0) wt[((wc * 4 + fq) * 2 + (fr >> 3)) * 8 + (fr & 7)] = wld;
        asm volatile("s_waitcnt lgkmcnt(0)" ::: "memory"); __builtin_amdgcn_s_barrier(); asm volatile("" ::: "memory");
#pragma unroll
        for (int n = 0; n < 2; ++n) {
            const int ch = u.pn * HALF + colq + 4 * n;
            f32x4 wg[3], wv[3];
#pragma unroll
            for (int j = 0; j < 3; ++j) { wg[j] = wt[((wc * 4 + fq) * 2 + n) * 8 + j]; wv[j] = wt[((wc * 4 + fq) * 2 + n) * 8 + 4 + j]; }
            const f32x4 bg = wt[((wc * 4 + fq) * 2 + n) * 8 + 3], bv = wt[((wc * 4 + fq) * 2 + n) * 8 + 7];
#pragma unroll
            for (int ai = 0; ai < 2; ++ai) {
                const int pb = ai * 2 + wr - 1;
#pragma unroll
                for (int m = 3; m >= 0; --m) {
                    float cg[4], cv[4];
#pragma unroll
                    for (int bj = 0; bj < 2; ++bj) {
                        const f32x4 cur = acc[ai][bj][m][n];
                        f32x4 p62 = (f32x4){0.f, 0.f, 0.f, 0.f}, p63 = p62;
                        if (m == 0 && pb >= 0) { p62 = *(const PG8_LAS f32x4*)(xb + (pb * 2 + 0) * 256 + bj * HALF + colq + 4 * n); p63 = *(const PG8_LAS f32x4*)(xb + (pb * 2 + 1) * 256 + bj * HALF + colq + 4 * n); }
#pragma unroll
                        for (int e = 0; e < 4; ++e) {
                            float o1, o2;
                            if (m > 0) { const float P = acc[ai][bj][m - 1][n][e]; o1 = dpp_mov<0x121>(P, P); o2 = dpp_mov<0x122>(P, P); }
                            else { o1 = p63[e]; o2 = (fr == 0) ? p62[e] : p63[e]; }
                            const float xm1 = dpp_mov<0x111>(o1, cur[e]), xm2 = dpp_mov<0x112>(o2, cur[e]);
                            const float c = bj ? (bv[e] + wv[0][e] * xm2 + wv[1][e] * xm1 + wv[2][e] * cur[e]) : (bg[e] + wg[0][e] * xm2 + wg[1][e] * xm1 + wg[2][e] * cur[e]);
                            if (bj) cv[e] = c; else cg[e] = c;
                        }
                    }
                    u32x2 w; w.x = cvt_pk_bf16(silu_e(cg[0]) * cv[0], silu_e(cg[1]) * cv[1]); w.y = cvt_pk_bf16(silu_e(cg[2]) * cv[2], silu_e(cg[3]) * cv[3]);
                    const int row = R0 + ai * HALF + wr * 64 + m * 16 + fr;
                    const bool skip = (ai == 0) && (m == 0) && (wr == 0) && (fr < 2) && !bstart;
                    if (!skip) *(u32x2*)(O + (size_t)row * ldc + ch) = w;
                }
            }
        }
      }
    }
};
template <class Epi, class Sched, bool ALIGN_EPI = false, bool SP2 = false>
__device__ __forceinline__ void gemm_phase(PG8_LAS unsigned char* lds, const Gemm g, const Sched& S, const Epi& E, const int tid_in) {
    const int tid = tid_in, wid = __builtin_amdgcn_readfirstlane(tid >> 6), lane = tid & 63, wr = wid >> 2, wc = wid & 3, fr = lane & 15, fq = lane >> 4;
    const int K = g.K, nt = K / BK;
    unsigned voffA[2], voffB[2];
#pragma unroll
    for (int i = 0; i < 2; ++i) { int R, C; stage_rc(tid * 16 + i * 8192, R, C); const int Rb = Epi::PERM ? ((R & ~31) + perm32(R & 31)) : R;
        voffA[i] = (unsigned)(R * g.lda + C) * 2u; voffB[i] = (unsigned)(Rb * K + C) * 2u; }
    const size_t kstep = (size_t)(BK * 2);
    const size_t hstepB = (size_t)HALF * K * 2, hstepA = (size_t)HALF * g.lda * 2;
    const size_t tstepA = 2 * hstepA, tstepB = 2 * hstepB;
    const unsigned ldsw = (unsigned)wid * 1024u;
    const int aoff = lds_byte(wr * 64 + fr, fq * 8), boff = lds_byte(wc * 32 + fr, fq * 8);
#define PG8_SA(b, h) (((b) * 2 + (h)) * HTB)
#define PG8_SB(b, h) ((4 + (b) * 2 + (h)) * HTB)
#define PG8_STAGE(bufoff, gbase, voff) do { _Pragma("unroll") for (int _i = 0; _i < 2; ++_i) \
        __builtin_amdgcn_global_load_lds((const unsigned*)((const char*)(gbase) + (voff)[_i]), (PG8_LAS unsigned*)(lds + (bufoff) + ldsw + _i * 8192), 16, 0, 0); } while (0)
#define PG8_LDA(dst, b, h) do { _Pragma("unroll") for (int m = 0; m < 4; ++m) _Pragma("unroll") for (int k = 0; k < 2; ++k) dst[m][k] = *(const PG8_LAS bf16x8*)(lds + PG8_SA(b, h) + aoff + m * 2048 + k * 1024); } while (0)
#define PG8_LDB(dst, b, h) do { _Pragma("unroll") for (int n = 0; n < 2; ++n) _Pragma("unroll") for (int k = 0; k < 2; ++k) dst[n][k] = *(const PG8_LAS bf16x8*)(lds + PG8_SB(b, h) + boff + n * 2048 + k * 1024); } while (0)
#define PG8_MMA(ai, bj, At, Bt) do { __builtin_amdgcn_s_setprio(1); _Pragma("unroll") for (int m = 0; m < 4; ++m) _Pragma("unroll") for (int n = 0; n < 2; ++n) _Pragma("unroll") for (int k = 0; k < 2; ++k) \
        acc[ai][bj][m][n] = __builtin_amdgcn_mfma_f32_16x16x32_bf16(Bt[n][k], At[m][k], acc[ai][bj][m][n], 0, 0, 0); __builtin_amdgcn_s_setprio(0); } while (0)
#define PG8_WAIT_V(n) asm volatile("s_waitcnt vmcnt(" #n ")" ::: "memory")
#define PG8_WAIT_L(n) asm volatile("s_waitcnt lgkmcnt(" #n ")" ::: "memory")
#define PG8_BAR __builtin_amdgcn_s_barrier()
#define PG8_SCHED __builtin_amdgcn_sched_barrier(0)
    Unit cur, nxt; int ui = 0;
    if (!S.next(0, cur)) return;
    f32x4 acc[2][2][4][2];
#pragma unroll
    for (int a = 0; a < 2; ++a)
#pragma unroll
        for (int b = 0; b < 2; ++b)
#pragma unroll
            for (int m = 0; m < 4; ++m)
#pragma unroll
                for (int n = 0; n < 2; ++n) acc[a][b][m][n] = (f32x4){0.f, 0.f, 0.f, 0.f};
    bf16x8 At[4][2], B0[2][2], B1[2][2];
    const char* cA = (const char*)g.A + (size_t)cur.pm * tstepA; const char* cB = (const char*)g.Bt + (size_t)cur.pn * tstepB;
    S.a_ready(cur);
    if constexpr (SP2) {
        PG8_STAGE(PG8_SB(0, 0), cB, voffB); PG8_STAGE(PG8_SB(0, 1), cB + hstepB, voffB); PG8_STAGE(PG8_SA(0, 0), cA, voffA); PG8_STAGE(PG8_SA(0, 1), cA + hstepA, voffA);
        if (wr == 1) PG8_BAR;
        PG8_WAIT_V(2); PG8_BAR;
        PG8_STAGE(PG8_SB(1, 0), cB + kstep, voffB); PG8_STAGE(PG8_SA(1, 0), cA + kstep, voffA); PG8_STAGE(PG8_SB(1, 1), cB + hstepB + kstep, voffB);
        PG8_WAIT_V(6); PG8_BAR;
    } else {
        PG8_STAGE(PG8_SB(0, 0), cB, voffB); PG8_STAGE(PG8_SA(0, 0), cA, voffA); PG8_STAGE(PG8_SB(0, 1), cB + hstepB, voffB); PG8_STAGE(PG8_SA(0, 1), cA + hstepA, voffA);
        if (wr == 1) PG8_BAR;
        PG8_WAIT_V(4); PG8_BAR;
        PG8_STAGE(PG8_SB(1, 0), cB + kstep, voffB); PG8_STAGE(PG8_SA(1, 0), cA + kstep, voffA); PG8_STAGE(PG8_SB(1, 1), cB + hstepB + kstep, voffB);
        PG8_WAIT_V(6); PG8_BAR;
    }
    for (;;) {
        const bool has_next = S.next(ui + 1, nxt);
        const char* nA = has_next ? (const char*)g.A + (size_t)nxt.pm * tstepA : cA; const char* nB = has_next ? (const char*)g.Bt + (size_t)nxt.pn * tstepB : cB;
        for (int t = 0; t < nt; t += 2) {
            const bool last = (t == nt - 2);
            const char* a1 = cA + (size_t)(t + 1) * kstep;
            const char* a2 = last ? nA : cA + (size_t)(t + 2) * kstep; const char* b2 = last ? nB : cB + (size_t)(t + 2) * kstep;
            const char* a3 = a2 + kstep; const char* b3 = b2 + kstep;
            if (last && has_next) S.a_ready(nxt);
            if constexpr (SP2) {
            PG8_LDB(B0, 0, 0); PG8_LDB(B1, 0, 1); PG8_SCHED; PG8_LDA(At, 0, 0); PG8_STAGE(PG8_SA(1, 1), a1 + hstepA, voffA);
            PG8_WAIT_V(8); PG8_WAIT_L(0); PG8_BAR; PG8_MMA(0, 0, At, B0); PG8_MMA(0, 1, At, B1); PG8_BAR; PG8_SCHED;
            PG8_LDA(At, 0, 1); PG8_STAGE(PG8_SB(0, 0), b2, voffB); PG8_STAGE(PG8_SB(0, 1), b2 + hstepB, voffB); PG8_STAGE(PG8_SA(0, 0), a2, voffA);
            PG8_WAIT_V(8); PG8_WAIT_L(0); PG8_BAR; PG8_MMA(1, 0, At, B0); PG8_MMA(1, 1, At, B1); PG8_BAR; PG8_SCHED;
            PG8_LDB(B0, 1, 0); PG8_LDB(B1, 1, 1); PG8_SCHED; PG8_LDA(At, 1, 0); PG8_STAGE(PG8_SA(0, 1), a2 + hstepA, voffA);
            PG8_WAIT_V(8); PG8_WAIT_L(0); PG8_BAR; PG8_MMA(0, 0, At, B0); PG8_MMA(0, 1, At, B1); PG8_BAR; PG8_SCHED;
            PG8_LDA(At, 1, 1); PG8_STAGE(PG8_SB(1, 0), b3, voffB); PG8_STAGE(PG8_SB(1, 1), b3 + hstepB, voffB); PG8_STAGE(PG8_SA(1, 0), a3, voffA);
            PG8_WAIT_V(8); PG8_WAIT_L(0); PG8_BAR; PG8_MMA(1, 0, At, B0); PG8_MMA(1, 1, At, B1); PG8_BAR; PG8_SCHED;
            } else {
            PG8_LDB(B0, 0, 0); PG8_SCHED; PG8_LDA(At, 0, 0); PG8_STAGE(PG8_SA(1, 1), a1 + hstepA, voffA);
            PG8_WAIT_L(8); PG8_BAR; PG8_WAIT_L(0); PG8_MMA(0, 0, At, B0); PG8_BAR; PG8_SCHED;
            PG8_LDB(B1, 0, 1); PG8_STAGE(PG8_SB(0, 0), b2, voffB);
            PG8_BAR; PG8_WAIT_L(0); PG8_MMA(0, 1, At, B1); PG8_BAR;
            PG8_LDA(At, 0, 1); PG8_STAGE(PG8_SA(0, 0), a2, voffA);
            PG8_BAR; PG8_WAIT_L(0); PG8_MMA(1, 0, At, B0); PG8_BAR; PG8_SCHED;
            PG8_STAGE(PG8_SB(0, 1), b2 + hstepB, voffB);
            PG8_WAIT_V(6); PG8_BAR; PG8_MMA(1, 1, At, B1); PG8_BAR;
            PG8_LDB(B0, 1, 0); PG8_SCHED; PG8_LDA(At, 1, 0); PG8_STAGE(PG8_SA(0, 1), a2 + hstepA, voffA);
            PG8_WAIT_L(8); PG8_BAR; PG8_WAIT_L(0); PG8_MMA(0, 0, At, B0); PG8_BAR; PG8_SCHED;
            PG8_LDB(B1, 1, 1); PG8_STAGE(PG8_SB(1, 0), b3, voffB);
            PG8_BAR; PG8_WAIT_L(0); PG8_MMA(0, 1, At, B1); PG8_BAR;
            PG8_LDA(At, 1, 1); PG8_STAGE(PG8_SA(1, 0), a3, voffA);
            PG8_BAR; PG8_WAIT_L(0); PG8_MMA(1, 0, At, B0); PG8_BAR; PG8_SCHED;
            PG8_STAGE(PG8_SB(1, 1), b3 + hstepB, voffB);
            PG8_WAIT_V(6); PG8_BAR; PG8_MMA(1, 1, At, B1); PG8_BAR;
            }
        }
        if constexpr (ALIGN_EPI) { if (wr == 0) PG8_BAR; }
        if constexpr (!Epi::AFTER_DRAIN) { E(acc, cur, wr, wc, fr, fq); S.done(cur); }
        if (!has_next) break;
#pragma unroll
        for (int a = 0; a < 2; ++a)
#pragma unroll
            for (int b = 0; b < 2; ++b)
#pragma unroll
                for (int m = 0; m < 4; ++m)
#pragma unroll
                    for (int n = 0; n < 2; ++n) acc[a][b][m][n] = (f32x4){0.f, 0.f, 0.f, 0.f};
        cur = nxt; cA = nA; cB = nB; ++ui;
        if constexpr (ALIGN_EPI) { if (wr == 1) PG8_BAR; }
    }
    PG8_WAIT_V(0);
    if constexpr (!ALIGN_EPI) { if (wr == 0) PG8_BAR; }
    PG8_BAR;
    if constexpr (Epi::AFTER_DRAIN) { E.fused(acc, cur, wr, wc, fr, fq, lds, wid, lane); S.done(cur); }
#undef PG8_SA
#undef PG8_SB
#undef PG8_STAGE
#undef PG8_LDA
#undef PG8_LDB
#undef PG8_MMA
#undef PG8_WAIT_V
#undef PG8_WAIT_L
#undef PG8_BAR
#undef PG8_SCHED
}
}

#include <hip/hip_bf16.h>
#include <cmath>
namespace attn_body {
using bf16=__hip_bfloat16;
using bf16x8=__attribute__((ext_vector_type(8)))short;
using s16x4=__attribute__((ext_vector_type(4)))short;
using f32x16=__attribute__((ext_vector_type(16)))float;
using u32x4=__attribute__((ext_vector_type(4)))unsigned;
constexpr int SEQ=4096,D=64,DM=3072,OP=1024;
constexpr int NW=8,QBLK=32,QB=QBLK*NW,KVBLK=64,NQB=SEQ/QB;
constexpr int ATTN_PITCH=DM, ATTN_UNIT_ROWS=QB;
__device__ __forceinline__ int crow(int r,int hi){return (r&3)+8*(r>>2)+4*hi;}
#define SBAR() __builtin_amdgcn_sched_barrier(0)
__device__ __forceinline__ void cmask(f32x16&p0,f32x16&p1,int jb,int qrel,int hi,int wq,float sl2){
  if(jb>wq){
    #pragma unroll
    for(int r=0;r<16;++r){p0[r]=-INFINITY;p1[r]=-INFINITY;}
  } else if(jb==wq){
    int kb=64*jb+4*hi-qrel; asm volatile("":"+v"(kb)); const float m2=-2.f*sl2;
    #pragma unroll
    for(int r=0;r<16;++r){const int d=kb+((r&3)+8*(r>>2)); const int d0=d>0?d:0; const int d1=(d+32)>0?(d+32):0; p0[r]=__builtin_fmaf(m2,(float)d0,p0[r]); p1[r]=__builtin_fmaf(m2,(float)d1,p1[r]);}
  }
}
constexpr int NSLOT=3, SLOTB=8192;
constexpr int LDS_K=0, LDS_V=NSLOT*SLOTB, LDS_WS=2*NSLOT*SLOTB, LDS_OST=LDS_WS+NW*64*4, LDS_BYTES=LDS_OST+NW*4096;
constexpr float C2=0.125f*1.4426950408889634f;
__device__ __forceinline__ void glds16(const void*gsrc,unsigned lds_dst){unsigned keep;
  asm volatile("s_mov_b32 %0, m0\n\ts_mov_b32 m0, %2\n\ts_nop 0\n\tglobal_load_lds_dwordx4 %1, off\n\ts_mov_b32 m0, %0":"=&s"(keep):"v"(gsrc),"s"(lds_dst):"memory");}
__device__ __forceinline__ float max3f(float a,float b,float c){float r;asm("v_max3_f32 %0, %1, %2, %3":"=v"(r):"v"(a),"v"(b),"v"(c));return r;}
__device__ __forceinline__ float max2f(float a,float b){float r;asm("v_max_f32_e32 %0, %1, %2":"=v"(r):"v"(a),"v"(b));return r;}
__device__ __forceinline__ float fadd_s(float a,float b){float r;asm("v_add_f32_e32 %0, %1, %2":"=v"(r):"v"(a),"v"(b));return r;}
__device__ __forceinline__ float fsub_s(float a,float b){float r;asm("v_sub_f32_e32 %0, %1, %2":"=v"(r):"v"(a),"v"(b));return r;}
typedef float f32x2_t __attribute__((ext_vector_type(2))); typedef __bf16 bf16x2_t __attribute__((ext_vector_type(2)));
__device__ __forceinline__ unsigned cvtpk_s(float lo,float hi){f32x2_t v={lo,hi};bf16x2_t b=__builtin_convertvector(v,bf16x2_t);return __builtin_bit_cast(unsigned,b);}
#define WAIT_BAR(N) asm volatile("s_waitcnt vmcnt(" #N ") lgkmcnt(0)\n\ts_barrier":::"memory")

__device__ __forceinline__ void qkt(f32x16&p0,f32x16&p1,const char*Kslot,const bf16x8*qr,const f32x16&negm,int r32,int hi){
  const char*kb=Kslot+r32*128; const int lp=((hi^(r32&7))<<4);
  #pragma unroll
  for(int d0=0;d0<4;++d0){
    const bf16x8 b0=*reinterpret_cast<const bf16x8*>(kb+(lp^(d0<<5)));
    const bf16x8 b1=*reinterpret_cast<const bf16x8*>(kb+(lp^(d0<<5))+4096);
    if(d0==0){p0=__builtin_amdgcn_mfma_f32_32x32x16_bf16(b0,qr[0],negm,0,0,0);p1=__builtin_amdgcn_mfma_f32_32x32x16_bf16(b1,qr[0],negm,0,0,0);}
    else{p0=__builtin_amdgcn_mfma_f32_32x32x16_bf16(b0,qr[d0],p0,0,0,0);p1=__builtin_amdgcn_mfma_f32_32x32x16_bf16(b1,qr[d0],p1,0,0,0);}}
}
typedef __attribute__((address_space(3))) const char* lds_cptr;
typedef short v4i16_t __attribute__((ext_vector_type(4)));
__device__ __forceinline__ void kload2(bf16x8*kf,lds_cptr kp,int j,int lp){ const lds_cptr a=kp+(lp^(j<<5)); kf[2*j]=*(const __attribute__((address_space(3))) bf16x8*)(a); kf[2*j+1]=*(const __attribute__((address_space(3))) bf16x8*)(a+4096); }
__device__ __forceinline__ void kload8(bf16x8*kf,lds_cptr kp,int lp){ kload2(kf,kp,0,lp); kload2(kf,kp,1,lp); kload2(kf,kp,2,lp); kload2(kf,kp,3,lp); }
__device__ __forceinline__ s16x4 vtr(lds_cptr p){ return __builtin_bit_cast(s16x4,__builtin_amdgcn_ds_read_tr16_b64_v4i16((__attribute__((address_space(3))) v4i16_t*)p)); }
__device__ __forceinline__ float rowmax(const f32x16&p0,const f32x16&p1){
  float a=max3f(p0[0],p0[1],p1[0]),b=max3f(p0[2],p0[3],p1[1]);a=max3f(a,p1[2],p1[3]);
  #pragma unroll
  for(int r=4;r<16;r+=4){a=max3f(a,p0[r],p0[r+1]);b=max3f(b,p0[r+2],p0[r+3]);a=max3f(a,p1[r],p1[r+1]);b=max3f(b,p1[r+2],p1[r+3]);}
  const float m=max2f(a,b);
  auto rr=__builtin_amdgcn_permlane32_swap(__float_as_uint(m),__float_as_uint(m),false,false);
  return max2f(__uint_as_float(rr[0]),__uint_as_float(rr[1]));
}
__device__ __forceinline__ void pv(f32x16*o,int vb,bf16x8 pa0,bf16x8 pa1,bf16x8 pa2,bf16x8 pa3){
  #pragma unroll
  for(int d0=0;d0<2;++d0){s16x4 lo[4],hi[4];
    #pragma unroll
    for(int ks=0;ks<4;++ks){
      asm volatile("ds_read_b64_tr_b16 %0,%1 offset:%c2":"=&v"(lo[ks]):"v"(vb),"i"(d0*4096+ks*1024):"memory");
      asm volatile("ds_read_b64_tr_b16 %0,%1 offset:%c2":"=&v"(hi[ks]):"v"(vb),"i"(d0*4096+ks*1024+512):"memory");}
    asm volatile("s_waitcnt lgkmcnt(0)":::"memory");SBAR();
    #define PK(k) (bf16x8){lo[k][0],lo[k][1],lo[k][2],lo[k][3],hi[k][0],hi[k][1],hi[k][2],hi[k][3]}
    o[d0]=__builtin_amdgcn_mfma_f32_32x32x16_bf16(pa0,PK(0),o[d0],0,0,0);
    o[d0]=__builtin_amdgcn_mfma_f32_32x32x16_bf16(pa1,PK(1),o[d0],0,0,0);
    o[d0]=__builtin_amdgcn_mfma_f32_32x32x16_bf16(pa2,PK(2),o[d0],0,0,0);
    o[d0]=__builtin_amdgcn_mfma_f32_32x32x16_bf16(pa3,PK(3),o[d0],0,0,0);
    #undef PK
  }
}

#ifndef ATTN_STORE16
#define ATTN_STORE16(p,v) (*(u32x4*)(p)=(v))
#endif
template<int THRL> __device__ __forceinline__ void attn_unit(int b,int qoff,int koff,int voff,int ooff,int hh,int qb,const bf16*PJ,bf16*O,char*shm,const int tid_in){
  const int tid=tid_in,lane=tid&63,r32=lane&31,hi=lane>>5; const int wid=__builtin_amdgcn_readfirstlane(tid>>6);
  const long rowbase=(long)b*SEQ; const int q0=qb*QB;
  const bf16*Qw=PJ+(rowbase+q0+wid*QBLK)*DM+qoff;
  const bf16*Kh=PJ+rowbase*DM+koff,*Vh=PJ+rowbase*DM+voff; const unsigned e_=(unsigned)(2*(hh+1))<<23; const float sl2=__builtin_bit_cast(float,0x3fb8aa3bu-e_), s2_=__builtin_bit_cast(float,0x3fb8aa3bu+(1u<<23)-e_), s3_=__builtin_bit_cast(float,0x408a7facu-e_), s8=__builtin_bit_cast(float,0x3fb8aa3bu+(3u<<23)-e_), s32_=__builtin_bit_cast(float,0x3fb8aa3bu+(5u<<23)-e_); const float hb=sl2*(float)(4*hi); const int wq=wid>>1; const f32x2_t c01={0.f,sl2},c23={s2_,s3_},c32={s32_,s32_};
  const unsigned lds0=(unsigned)(uintptr_t)shm;
  float*wsf=(float*)(shm+LDS_WS)+wid*64;
  const bf16*ksrc=Kh+(long)(8*wid+(lane>>3))*DM+(((lane&7)^(lane>>3))*8); const int lp=((hi^(r32&7))<<4);
  const bf16*vsrc=Vh+(long)(16*(wid&3)+(lane>>2))*DM+(wid>>2)*32+(lane&3)*8;
  const unsigned kdst=lds0+LDS_K+wid*1024, vdst=lds0+LDS_V+wid*1024;
  #define DMA_K(t,slot) glds16(ksrc+(long)(t)*KVBLK*DM,(unsigned)__builtin_amdgcn_readfirstlane(kdst+(slot)))
  #define DMA_V(t,slot) glds16(vsrc+(long)(t)*KVBLK*DM,(unsigned)__builtin_amdgcn_readfirstlane(vdst+(slot)))
  const int vb0=(int)(lds0+LDS_V)+((lane>>4)&1)*32+(lane&3)*8+(4*hi+((lane&15)>>2))*64;
  const char*Kbase=shm+LDS_K; bf16x8 kf[8];
  const lds_cptr shm3=(lds_cptr)shm; const lds_cptr kp0=shm3+LDS_K+r32*128; const lds_cptr vp0=shm3+LDS_V+((lane>>4)&1)*32+(lane&3)*8+(4*hi+((lane&15)>>2))*64;
  const int NT=(q0+QB)/KVBLK;
  DMA_K(0,0);DMA_V(0,0);DMA_K(1,SLOTB);
  bf16x8 qr[4];
  #pragma unroll
  for(int d0=0;d0<4;++d0)qr[d0]=*reinterpret_cast<const bf16x8*>(&Qw[(long)r32*DM+d0*16+hi*8]);
  float mhat=0.f,l_reg=0.f;f32x16 o[2];o[0]=f32x16{};o[1]=f32x16{};const f32x16 negm=f32x16{};
  const int qrel=wid*QBLK+r32;
  #define BIAS(P0,P1,t) do{ float tg_=hb-mhat; asm volatile("":"+v"(tg_)); tg_+=sl2*(float)(64*(t)); _Pragma("unroll") for(int g=0;g<4;++g){ const f32x2_t t2_={tg_,tg_}; const f32x2_t a_=t2_+c01, b_=t2_+c23, c_=a_+c32, d_=b_+c32; P0[4*g]+=a_.x; P0[4*g+1]+=a_.y; P0[4*g+2]+=b_.x; P0[4*g+3]+=b_.y; P1[4*g]+=c_.x; P1[4*g+1]+=c_.y; P1[4*g+2]+=d_.x; P1[4*g+3]+=d_.y; tg_+=s8; } }while(0)
  #define CMASK(P0,P1,t) do{int jb_=(t)-(NT-4); if(jb_>=0)cmask(P0,P1,jb_,qrel,hi,wq,sl2);}while(0)
  bool resc=false;
  #define START(P0,P1) do{ const float rm=rowmax(P0,P1); resc=false; \
    { const float dl=rm; mhat=fadd_s(mhat,dl); \
      _Pragma("unroll") for(int r=0;r<16;++r){P0[r]=fsub_s(P0[r],dl);P1[r]=fsub_s(P1[r],dl);} \
      } \
    _Pragma("unroll") for(int r=0;r<16;++r)P0[r]=__builtin_amdgcn_exp2f(P0[r]); }while(0)
  #define RESC() do{ if(resc){ asm volatile("s_waitcnt lgkmcnt(0)":::"memory"); \
      _Pragma("unroll") for(int d_=0;d_<2;++d_) _Pragma("unroll") for(int r=0;r<16;++r)o[d_][r]*=wsf[crow(r,hi)]; } }while(0)
  f32x16 pA0,pA1,pB0,pB1;
  int sl_prev=0,sl_cur=0,sl_next=SLOTB;
  #define ROT() do{sl_prev=sl_cur;sl_cur=sl_next;sl_next=(sl_next==(NSLOT-1)*SLOTB)?0:sl_next+SLOTB;}while(0)
  DMA_K(2,2*SLOTB);
  WAIT_BAR(3);
  qkt(pA0,pA1,Kbase,qr,negm,r32,hi);asm volatile("s_nop 15\n\ts_nop 7":"+v"(pA0),"+v"(pA1));BIAS(pA0,pA1,0);CMASK(pA0,pA1,0);
  START(pA0,pA1);
  _Pragma("unroll") for(int r=0;r<16;++r)pA1[r]=__builtin_amdgcn_exp2f(pA1[r]);
  WAIT_BAR(0);
  DMA_K(3,0);DMA_V(1,SLOTB);
  ROT();
  kload8(kf,kp0+sl_cur,lp);
  WAIT_BAR(2);
  s16x4 vlo[8],vhi[8]; u32x4 pw0,pw1,pw2,pw3;
  #define PKW(P,B) cvtpk_s(P[B],P[B+1])
  #define PAF(k) __builtin_bit_cast(bf16x8,pw##k)
  #define VFR(i) (bf16x8){vlo[i][0],vlo[i][1],vlo[i][2],vlo[i][3],vhi[i][0],vhi[i][1],vhi[i][2],vhi[i][3]}
  #define PIN(x) asm volatile("":"+v"(x))
  #define MX3(a,b,c) __builtin_fmaxf(__builtin_fmaxf((a),(b)),(c))
  #define GAPA(MF,A0,A1,A2,A3,W0,W1,PW) do{ MF; sacc+=A0; sacc+=A1; sacc+=A2; sacc+=A3; PIN(sacc); W0; W1; PIN(PW); SBAR(); }while(0)
  #define EX(v) __builtin_amdgcn_exp2f(v)
  #define GAPB(MF,X,B) do{ MF; X[B]=EX(X[B]); X[B+1]=EX(X[B+1]); X[B+2]=EX(X[B+2]); X[B+3]=EX(X[B+3]); PIN(X); SBAR(); }while(0)
  #define VRD(i) do{ vlo[i]=vtr(vp_+(((i)>>2)*4096+((i)&3)*1024)); vhi[i]=vtr(vp_+(((i)>>2)*4096+((i)&3)*1024+512)); }while(0)
  #define KRD(G,j) do{ if(G){ kload2(kf,kp0+sl_next,j,lp); SBAR(); } }while(0)
  #define STEP(C0,C1,P0,P1,t,GK,GV,GL) do{ SBAR(); \
    const lds_cptr vp_=vp0+sl_prev; \
    VRD(0); SBAR(); float sacc=(P0[0]+P0[1]); \
    GAPA(C0=__builtin_amdgcn_mfma_f32_32x32x16_bf16(kf[0],qr[0],negm,0,0,0), P0[2],P0[3],P0[4],P0[5],     pw0[0]=PKW(P0,0), pw0[1]=PKW(P0,2), pw0); \
    VRD(4); SBAR(); GAPA(C1=__builtin_amdgcn_mfma_f32_32x32x16_bf16(kf[1],qr[0],negm,0,0,0), P0[6],P0[7],P0[8],P0[9],     pw0[2]=PKW(P0,4), pw0[3]=PKW(P0,6), pw0); \
    VRD(1); SBAR(); GAPA(C0=__builtin_amdgcn_mfma_f32_32x32x16_bf16(kf[2],qr[1],C0,0,0,0),   P0[10],P0[11],P0[12],P0[13], pw1[0]=PKW(P0,8), pw1[1]=PKW(P0,10), pw1); \
    VRD(5); SBAR(); GAPA(C1=__builtin_amdgcn_mfma_f32_32x32x16_bf16(kf[3],qr[1],C1,0,0,0),   P0[14],P0[15],P1[0],P1[1],   pw1[2]=PKW(P0,12),pw1[3]=PKW(P0,14), pw1); \
    VRD(2); SBAR(); GAPA(C0=__builtin_amdgcn_mfma_f32_32x32x16_bf16(kf[4],qr[2],C0,0,0,0),   P1[2],P1[3],P1[4],P1[5],     pw2[0]=PKW(P1,0), pw2[1]=PKW(P1,2), pw2); \
    VRD(6); SBAR(); GAPA(C1=__builtin_amdgcn_mfma_f32_32x32x16_bf16(kf[5],qr[2],C1,0,0,0),   P1[6],P1[7],P1[8],P1[9],     pw2[2]=PKW(P1,4), pw2[3]=PKW(P1,6), pw2); \
    VRD(3); SBAR(); GAPA(C0=__builtin_amdgcn_mfma_f32_32x32x16_bf16(kf[6],qr[3],C0,0,0,0),   P1[10],P1[11],P1[12],P1[13], pw3[0]=PKW(P1,8), pw3[1]=PKW(P1,10), pw3); \
    VRD(7); SBAR(); GAPA(C1=__builtin_amdgcn_mfma_f32_32x32x16_bf16(kf[7],qr[3],C1,0,0,0),   P1[14],P1[15],0.f,0.f,       pw3[2]=PKW(P1,12),pw3[3]=PKW(P1,14), pw3); \
    l_reg+=sacc; \
    if(GK){DMA_K((t)+3,sl_cur);} if(GV){DMA_V((t)+1,sl_next);} \
    BIAS(C0,C1,t); CMASK(C0,C1,t); \
    { float a=MX3(C0[0],C0[1],C1[0]),b=MX3(C0[2],C0[3],C1[1]); a=MX3(a,C1[2],C1[3]); \
      _Pragma("unroll") for(int r=4;r<16;r+=4){a=MX3(a,C0[r],C0[r+1]);b=MX3(b,C0[r+2],C0[r+3]);a=MX3(a,C1[r],C1[r+1]);b=MX3(b,C1[r+2],C1[r+3]);} \
      float rm=__builtin_fmaxf(a,b); { auto rr=__builtin_amdgcn_permlane32_swap(__float_as_uint(rm),__float_as_uint(rm),false,false); rm=__builtin_fmaxf(__uint_as_float(rr[0]),__uint_as_float(rr[1])); } \
      resc=false; \
      if(__builtin_expect(__any(rm>(float)THRL),0)){ const float dl=__builtin_fmaxf(rm,0.f); mhat+=dl; \
        _Pragma("unroll") for(int r=0;r<16;++r){C0[r]-=dl;C1[r]-=dl;} \
        const float f=__builtin_amdgcn_exp2f(-dl); l_reg*=f; if(hi==0)wsf[r32]=f; resc=true; } } \
    SBAR(); \
    GAPB(o[0]=__builtin_amdgcn_mfma_f32_32x32x16_bf16(PAF(0),VFR(0),o[0],0,0,0), C0,0); \
    GAPB(o[1]=__builtin_amdgcn_mfma_f32_32x32x16_bf16(PAF(0),VFR(4),o[1],0,0,0), C0,4); \
    KRD(GL,0); GAPB(o[0]=__builtin_amdgcn_mfma_f32_32x32x16_bf16(PAF(1),VFR(1),o[0],0,0,0), C0,8); \
    KRD(GL,1); GAPB(o[1]=__builtin_amdgcn_mfma_f32_32x32x16_bf16(PAF(1),VFR(5),o[1],0,0,0), C0,12); \
    KRD(GL,2); GAPB(o[0]=__builtin_amdgcn_mfma_f32_32x32x16_bf16(PAF(2),VFR(2),o[0],0,0,0), C1,0); \
    KRD(GL,3); GAPB(o[1]=__builtin_amdgcn_mfma_f32_32x32x16_bf16(PAF(2),VFR(6),o[1],0,0,0), C1,4); \
    GAPB(o[0]=__builtin_amdgcn_mfma_f32_32x32x16_bf16(PAF(3),VFR(3),o[0],0,0,0), C1,8); \
    GAPB(o[1]=__builtin_amdgcn_mfma_f32_32x32x16_bf16(PAF(3),VFR(7),o[1],0,0,0), C1,12); \
    }while(0)
  int t=1;
  #undef CMASK
  #define CMASK(P0,P1,t) do{}while(0)
  for(;t+5<NT;t+=2){
    STEP(pB0,pB1,pA0,pA1,t,true,true,true);     WAIT_BAR(2); RESC(); ROT();
    STEP(pA0,pA1,pB0,pB1,t+1,true,true,true);   WAIT_BAR(2); RESC(); ROT();
  }
  #undef CMASK
  #define CMASK(P0,P1,t) do{int jb_=(t)-(NT-4); if(jb_>=0)cmask(P0,P1,jb_,qrel,hi,wq,sl2);}while(0)
  #define ENDW(tt) do{ if((tt)+3<NT){WAIT_BAR(2);} else if((tt)+2<NT){WAIT_BAR(1);} else {WAIT_BAR(0);} }while(0)
  for(;t+1<NT;t+=2){
    STEP(pB0,pB1,pA0,pA1,t,(t+3<NT),(t+1<NT),(t+1<NT));       ENDW(t);   RESC(); ROT();
    STEP(pA0,pA1,pB0,pB1,t+1,(t+4<NT),(t+2<NT),(t+2<NT));     ENDW(t+1); RESC(); ROT();
  }
  STEP(pB0,pB1,pA0,pA1,NT-1,false,false,false); RESC();
  { float sacc=pB0[0]+pB0[1]; _Pragma("unroll") for(int r=2;r<16;++r)sacc+=pB0[r]; _Pragma("unroll") for(int r=0;r<16;++r)sacc+=pB1[r]; l_reg+=sacc;
    pw0=(u32x4){PKW(pB0,0),PKW(pB0,2),PKW(pB0,4),PKW(pB0,6)};pw1=(u32x4){PKW(pB0,8),PKW(pB0,10),PKW(pB0,12),PKW(pB0,14)};pw2=(u32x4){PKW(pB1,0),PKW(pB1,2),PKW(pB1,4),PKW(pB1,6)};pw3=(u32x4){PKW(pB1,8),PKW(pB1,10),PKW(pB1,12),PKW(pB1,14)};
    SBAR(); pv(o,vb0+sl_cur,PAF(0),PAF(1),PAF(2),PAF(3)); }
  #undef PKW
  #undef PAF
  #undef VFR
  #undef PIN
  #undef MX3
  #undef GAPA
  #undef GAPB
  #undef EX
  #undef VRD
  #undef KRD
  #undef STEP
  #undef ENDW
  {auto rr=__builtin_amdgcn_permlane32_swap(__float_as_uint(l_reg),__float_as_uint(l_reg),false,false);l_reg=__uint_as_float(rr[0])+__uint_as_float(rr[1]);}
  if(hi==0)wsf[32+r32]=l_reg;asm volatile("s_waitcnt lgkmcnt(0)":::"memory");
  float rli[16];
  #pragma unroll
  for(int r=0;r<16;++r)rli[r]=__builtin_amdgcn_rcpf(wsf[32+crow(r,hi)]);
  bf16*Ow=O+(rowbase+q0+wid*QBLK)*OP+ooff;
  { bf16*stg=(bf16*)(shm+LDS_OST)+wid*2048;
    #pragma unroll
    for(int r=0;r<16;++r){const int orow=crow(r,hi);
      #pragma unroll
      for(int d0=0;d0<2;++d0)stg[orow*64+d0*32+r32]=__float2bfloat16(o[d0][r]*rli[r]);}
    asm volatile("s_waitcnt lgkmcnt(0)":::"memory");
    #pragma unroll
    for(int i=0;i<4;++i){const int row=i*8+(lane>>3),ch=lane&7; const u32x4 v=*(const u32x4*)(stg+row*64+ch*8); ATTN_STORE16(Ow+(long)row*OP+ch*8,v);} }
  asm volatile("s_waitcnt lgkmcnt(0)\n\ts_barrier":::"memory");
  #undef BIAS
  #undef DMA_K
  #undef DMA_V
  #undef CMASK
  #undef START
  #undef RESC
  #undef ROT
}
constexpr int ATTN_LDS_BYTES=LDS_BYTES;
#undef SBAR
#undef WAIT_BAR
}

namespace cg = cooperative_groups;
#define LAS __attribute__((address_space(3)))
typedef unsigned short bf16;
typedef unsigned v4u __attribute__((ext_vector_type(4)));
typedef unsigned v2u __attribute__((ext_vector_type(2)));
typedef float f32x4 __attribute__((ext_vector_type(4)));
typedef float f32x16v __attribute__((ext_vector_type(16)));
typedef short bf16x8 __attribute__((ext_vector_type(8)));
#define LDS_WAIT() asm volatile("s_waitcnt lgkmcnt(0)" ::: "memory")
#define VM_WAIT() asm volatile("s_waitcnt vmcnt(0)" ::: "memory")

constexpr int BATCH = 8, SEQ = 4096, DMODEL = 1024, M = BATCH * SEQ, INW = 3072, FF = 2816, FF2 = 5632, NMOD = 6 * DMODEL;
constexpr float RMS_EPS = 1e-6f;
constexpr float LOG2E = 1.4426950408889634f;
constexpr int C_DAQ = 0, C_DAK = 512, C_DAV = 1024, C_RQ = 1536, C_RK = 1792, C_RV = 2048, C_RG = 2560;
constexpr size_t MiB = 1u << 20;
constexpr size_t WS_CTL = 0, CTL_ZERO_BYTES = 16384;
constexpr size_t WS_MOD = CTL_ZERO_BYTES;
constexpr size_t WS_WIN = 2 * MiB, WS_WOUT = 8 * MiB, WS_WUP = 10 * MiB, WS_WDN = 21 * MiB;
constexpr size_t WS_PROJ = 32 * MiB;
constexpr size_t WS_OTMP = 224 * MiB;
constexpr size_t WS_MIX = 288 * MiB;
constexpr size_t WS_Y = 352 * MiB;
constexpr size_t WS_XN = 448 * MiB;
constexpr size_t WS_A2 = 32 * MiB;
constexpr size_t WS_RAWF = 384 * MiB, WS_RAWL = 390 * MiB;
constexpr size_t WS_X1B = 224 * MiB;
constexpr size_t WS_F = 400 * MiB;
constexpr size_t WS_END = 512 * MiB;
constexpr int LDS_BYTES = 147456;
constexpr int NWAVES = 8;

__device__ __forceinline__ unsigned f2bf(float f) { unsigned u = __builtin_bit_cast(unsigned, f); return (u + 0x7fffu + ((u >> 16) & 1u)) >> 16; }
__device__ __forceinline__ unsigned pk2(float lo, float hi) { return f2bf(lo) | (f2bf(hi) << 16); }
__device__ __forceinline__ float bflo(unsigned u) { return __builtin_bit_cast(float, u << 16); }
__device__ __forceinline__ float bfhi(unsigned u) { return __builtin_bit_cast(float, u & 0xffff0000u); }
__device__ __forceinline__ float wave_sum(float v) {
#pragma unroll
    for (int o = 1; o < 64; o <<= 1) v += __shfl_xor(v, o);
    return v;
}
__device__ __forceinline__ float silu_f(float v) { return v / (1.f + __expf(-v)); }

struct Args { const float* in[19]; float* out; unsigned char* ws; int ph_lo, ph_hi; };
enum { I_X = 0, I_C, I_WADA, I_BADA, I_GPREMIX, I_WIN, I_LQ1, I_LK1, I_LQ2, I_LK2, I_GSUB, I_WOUT, I_GPOSTMIX, I_GPREFFN, I_WUP, I_CONVW, I_CONVB, I_WDOWN, I_GPOSTFFN };

__device__ __forceinline__ void p0_transpose_item(const float* W, int K, int N, bf16* WT, LAS float* scr, int item, int lane, bool perm_up) {
    const int nblk = N / 32, kb = item / nblk, nb = item % nblk, k0 = 64 * kb, n0 = 32 * nb;
    const int orow0 = !perm_up ? n0 : (n0 < FF ? 256 * (n0 >> 7) + (n0 & 127) : 256 * ((n0 - FF) >> 7) + 128 + ((n0 - FF) & 127));
    float t_[32];
#pragma unroll
    for (int i = 0; i < 32; ++i) { const int kk = 2 * i + (lane >> 5); t_[i] = W[(size_t)(k0 + kk) * N + n0 + (lane & 31)]; }
#pragma unroll
    for (int i = 0; i < 32; ++i) { const int kk = 2 * i + (lane >> 5); scr[kk * 33 + (lane & 31)] = t_[i]; }
    LDS_WAIT(); asm volatile("" ::: "memory");
    const int c = lane & 7;
#pragma unroll
    for (int j = 0; j < 4; ++j) { const int n = (lane >> 3) + 8 * j; const LAS float* s = scr + (8 * c) * 33 + n;
        v4u o; o.x = pk2(s[0 * 33], s[1 * 33]); o.y = pk2(s[2 * 33], s[3 * 33]); o.z = pk2(s[4 * 33], s[5 * 33]); o.w = pk2(s[6 * 33], s[7 * 33]);
        *(v4u*)(WT + (size_t)(orow0 + n) * K + k0 + 8 * c) = o; }
    LDS_WAIT(); asm volatile("" ::: "memory");
}
__device__ __forceinline__ void p0_mod_item(const float* c, const float* wada, const float* bada, float* mod, LAS float* scr, int item, int lane) {
    const int nb = item % 96, kc = item / 96, n = nb * 64 + lane;
#pragma unroll
    for (int b = 0; b < 8; ++b) scr[lane * 8 + b] = silu_f(c[b * DMODEL + kc * 64 + lane]);
    LDS_WAIT(); asm volatile("" ::: "memory");
    float acc[8];
#pragma unroll
    for (int b = 0; b < 8; ++b) acc[b] = 0.f;
    const float* wp = wada + (size_t)(kc * 64) * NMOD + n;
#pragma unroll 1
    for (int k0 = 0; k0 < 64; k0 += 16) {
        float wv_[16];
#pragma unroll
        for (int q = 0; q < 16; ++q) wv_[q] = wp[(size_t)(k0 + q) * NMOD];
#pragma unroll
        for (int q = 0; q < 16; ++q) { const float w = wv_[q]; const int kk = k0 + q; const f32x4 s0 = *(const LAS f32x4*)(scr + kk * 8), s1 = *(const LAS f32x4*)(scr + kk * 8 + 4);
            acc[0] += s0[0] * w; acc[1] += s0[1] * w; acc[2] += s0[2] * w; acc[3] += s0[3] * w; acc[4] += s1[0] * w; acc[5] += s1[1] * w; acc[6] += s1[2] * w; acc[7] += s1[3] * w; }
    }
    const float bb = (kc == 0) ? bada[n] : 0.f;
#pragma unroll
    for (int b = 0; b < 8; ++b) atomicAdd(mod + b * NMOD + n, acc[b] + bb);
    LDS_WAIT(); asm volatile("" ::: "memory");
}
__device__ __forceinline__ float sumsq4(const f32x4 v) { return (v.x * v.x + v.y * v.y) + (v.z * v.z + v.w * v.w); }
__device__ __forceinline__ f32x4 unpk4(const v2u w) { return (f32x4){bflo(w.x), bfhi(w.x), bflo(w.y), bfhi(w.y)}; }
__device__ __forceinline__ void p1_rows(const float* x, const float* g, const float* mod, bf16* XN, int m0, int step, int lane) {
    f32x4 vn[4];
    if (m0 < M) {
#pragma unroll
        for (int j = 0; j < 4; ++j) vn[j] = ((const f32x4*)(x + (size_t)m0 * DMODEL))[lane + 64 * j]; }
    for (int m = m0; m < M; m += step) {
        f32x4 v[4]; float ss = 0.f;
#pragma unroll
        for (int j = 0; j < 4; ++j) { v[j] = vn[j]; ss += sumsq4(v[j]); }
        if (m + step < M) {
#pragma unroll
            for (int j = 0; j < 4; ++j) vn[j] = ((const f32x4*)(x + (size_t)(m + step) * DMODEL))[lane + 64 * j]; }
        const float* modb = mod + (m / SEQ) * NMOD;
        const float rstd = __builtin_amdgcn_rsqf(wave_sum(ss) * (1.f / DMODEL) + RMS_EPS);
        v2u* o8 = (v2u*)(XN + (size_t)m * DMODEL) + lane;
#pragma unroll
        for (int j = 0; j < 4; ++j) { const f32x4 g4 = ((const f32x4*)g)[lane + 64 * j], sh = ((const f32x4*)modb)[lane + 64 * j], sc = ((const f32x4*)(modb + DMODEL))[lane + 64 * j];
            const f32x4 o = v[j] * rstd * g4 * (sc + 1.f) + sh; v2u w; w.x = pk2(o.x, o.y); w.y = pk2(o.z, o.w); o8[64 * j] = w; }
    }
}
__device__ __forceinline__ void wave_sum2(float& a, float& b) {
#pragma unroll
    for (int o = 1; o < 64; o <<= 1) { const float ta = __shfl_xor(a, o), tb = __shfl_xor(b, o); a += ta; b += tb; }
}
__device__ __forceinline__ void p5_rows(const float* x, const bf16* Y, const float* gpm, const float* gpf, const float* mod, bf16* X1B, bf16* XN, int m0, int step, int lane) {
    f32x4 vn[2][4]; v2u yn[2][4];
#pragma unroll
    for (int r = 0; r < 2; ++r) { const int mr = m0 + r * step; if (mr < M) {
#pragma unroll
        for (int j = 0; j < 4; ++j) { vn[r][j] = ((const f32x4*)(x + (size_t)mr * DMODEL))[lane + 64 * j]; yn[r][j] = ((const v2u*)(Y + (size_t)mr * DMODEL))[lane + 64 * j]; } } }
    for (int m = m0; m < M; m += 2 * step) {
        f32x4 v[2][4], y[2][4]; float ss[2] = {0.f, 0.f};
        const bool has1 = (m + step) < M;
#pragma unroll
        for (int r = 0; r < 2; ++r)
#pragma unroll
            for (int j = 0; j < 4; ++j) { v[r][j] = vn[r][j]; y[r][j] = unpk4(yn[r][j]); ss[r] += sumsq4(y[r][j]); }
#pragma unroll
        for (int r = 0; r < 2; ++r) { const int mr = m + (2 + r) * step; if (mr < M) {
#pragma unroll
            for (int j = 0; j < 4; ++j) { vn[r][j] = ((const f32x4*)(x + (size_t)mr * DMODEL))[lane + 64 * j]; yn[r][j] = ((const v2u*)(Y + (size_t)mr * DMODEL))[lane + 64 * j]; } } }
        wave_sum2(ss[0], ss[1]);
        float s2[2] = {0.f, 0.f};
#pragma unroll
        for (int r = 0; r < 2; ++r) { if (r == 1 && !has1) break;
            const int mr = m + r * step; const float* modb = mod + (mr / SEQ) * NMOD;
            const float rstd = __builtin_amdgcn_rsqf(ss[r] * (1.f / DMODEL) + RMS_EPS);
#pragma unroll
            for (int j = 0; j < 4; ++j) { const f32x4 g4 = ((const f32x4*)gpm)[lane + 64 * j], gt = ((const f32x4*)(modb + 2 * DMODEL))[lane + 64 * j];
                v[r][j] = v[r][j] + gt * (y[r][j] * rstd * g4); { v2u w; w.x = pk2(v[r][j].x, v[r][j].y); w.y = pk2(v[r][j].z, v[r][j].w); ((v2u*)(X1B + (size_t)mr * DMODEL))[lane + 64 * j] = w; } s2[r] += sumsq4(v[r][j]); } }
        wave_sum2(s2[0], s2[1]);
#pragma unroll
        for (int r = 0; r < 2; ++r) { if (r == 1 && !has1) break;
            const int mr = m + r * step; const float* modb = mod + (mr / SEQ) * NMOD;
            const float rstd2 = __builtin_amdgcn_rsqf(s2[r] * (1.f / DMODEL) + RMS_EPS);
            v2u* o8 = (v2u*)(XN + (size_t)mr * DMODEL) + lane;
#pragma unroll
            for (int j = 0; j < 4; ++j) { const f32x4 g4 = ((const f32x4*)gpf)[lane + 64 * j], sh = ((const f32x4*)(modb + 3 * DMODEL))[lane + 64 * j], sc = ((const f32x4*)(modb + 4 * DMODEL))[lane + 64 * j];
                const f32x4 o = v[r][j] * rstd2 * g4 * (sc + 1.f) + sh; v2u w; w.x = pk2(o.x, o.y); w.y = pk2(o.z, o.w); o8[64 * j] = w; } }
    }
}
__device__ __forceinline__ void p9_rows(float* out, const bf16* X1B, const bf16* F, const float* gpost, const float* mod, int m0, int step, int lane) {
    v2u xn[4], yn[4];
    if (m0 < M) {
#pragma unroll
        for (int j = 0; j < 4; ++j) { xn[j] = ((const v2u*)(X1B + (size_t)m0 * DMODEL))[lane + 64 * j]; yn[j] = ((const v2u*)(F + (size_t)m0 * DMODEL))[lane + 64 * j]; } }
    for (int m = m0; m < M; m += step) {
        f32x4 v[4], y[4]; float ss = 0.f;
#pragma unroll
        for (int j = 0; j < 4; ++j) { v[j] = unpk4(xn[j]); y[j] = unpk4(yn[j]); ss += sumsq4(y[j]); }
        if (m + step < M) {
#pragma unroll
            for (int j = 0; j < 4; ++j) { xn[j] = ((const v2u*)(X1B + (size_t)(m + step) * DMODEL))[lane + 64 * j]; yn[j] = ((const v2u*)(F + (size_t)(m + step) * DMODEL))[lane + 64 * j]; } }
        const float* modb = mod + (m / SEQ) * NMOD;
        const float rstd = __builtin_amdgcn_rsqf(wave_sum(ss) * (1.f / DMODEL) + RMS_EPS);
        f32x4* xp = (f32x4*)(out + (size_t)m * DMODEL) + lane;
#pragma unroll
        for (int j = 0; j < 4; ++j) { const f32x4 g4 = ((const f32x4*)gpost)[lane + 64 * j], gt = ((const f32x4*)(modb + 5 * DMODEL))[lane + 64 * j];
            xp[64 * j] = v[j] + gt * (y[j] * rstd * g4); }
    }
}

__device__ __forceinline__ void unpack8(const v4u w, float (&f)[8]) { f[0] = bflo(w.x); f[1] = bfhi(w.x); f[2] = bflo(w.y); f[3] = bfhi(w.y); f[4] = bflo(w.z); f[5] = bfhi(w.z); f[6] = bflo(w.w); f[7] = bfhi(w.w); }
__device__ __forceinline__ void conv_fixup(int pm, const float* rawf, const float* rawl, const float* cw, const float* cb, bf16* A2, int tid) {
    const int R0 = pm * 256; if ((R0 & (SEQ - 1)) == 0) return;
    const float* l0 = rawl + ((size_t)(pm - 1) * 2 + 0) * FF2; const float* l1 = l0 + FF2; const float* f0 = rawf + ((size_t)pm * 2 + 0) * FF2; const float* f1 = f0 + FF2;
#pragma unroll 1
    for (int slot = tid; slot < FF / 4; slot += 512) {
        const int ch = 4 * slot, gi = 256 * (ch >> 7) + (ch & 127), vi = gi + 128;
        const f32x4 g2 = *(const f32x4*)(l0 + gi), g1 = *(const f32x4*)(l1 + gi), ga = *(const f32x4*)(f0 + gi), gb = *(const f32x4*)(f1 + gi);
        const f32x4 v2 = *(const f32x4*)(l0 + vi), v1 = *(const f32x4*)(l1 + vi), va = *(const f32x4*)(f0 + vi), vb = *(const f32x4*)(f1 + vi);
        const f32x4 w0g = *(const f32x4*)(cw + ch), w1g = *(const f32x4*)(cw + FF2 + ch), w2g = *(const f32x4*)(cw + 2 * FF2 + ch), bgv = *(const f32x4*)(cb + ch);
        const f32x4 w0v = *(const f32x4*)(cw + FF + ch), w1v = *(const f32x4*)(cw + FF2 + FF + ch), w2v = *(const f32x4*)(cw + 2 * FF2 + FF + ch), bvv = *(const f32x4*)(cb + FF + ch);
        const f32x4 cg0 = bgv + w0g * g2 + w1g * g1 + w2g * ga, cv0 = bvv + w0v * v2 + w1v * v1 + w2v * va;
        const f32x4 cg1 = bgv + w0g * g1 + w1g * ga + w2g * gb, cv1 = bvv + w0v * v1 + w1v * va + w2v * vb;
        v2u o0, o1; o0.x = pk2(silu_f(cg0.x) * cv0.x, silu_f(cg0.y) * cv0.y); o0.y = pk2(silu_f(cg0.z) * cv0.z, silu_f(cg0.w) * cv0.w);
        o1.x = pk2(silu_f(cg1.x) * cv1.x, silu_f(cg1.y) * cv1.y); o1.y = pk2(silu_f(cg1.z) * cv1.z, silu_f(cg1.w) * cv1.w);
        *(v2u*)(A2 + (size_t)R0 * FF + ch) = o0; *(v2u*)(A2 + (size_t)(R0 + 1) * FF + ch) = o1;
    }
}

__device__ __forceinline__ void da_combine(int b, int h, int qb, const bf16* OT, bf16* MIX, const float* gsub, float lam, int tid) {
    const size_t row = (size_t)b * SEQ + qb * 256 + (tid >> 1); const int half = tid & 1;
    const v4u* p1 = (const v4u*)(OT + row * DMODEL + (h * 4 + half) * 64);
    const v4u* p2 = (const v4u*)(OT + row * DMODEL + (h * 4 + 2 + half) * 64);
    float d[64]; float ss = 0.f;
#pragma unroll
    for (int j = 0; j < 8; ++j) { float a[8], c[8]; unpack8(p1[j], a); unpack8(p2[j], c);
#pragma unroll
        for (int e = 0; e < 8; ++e) { const float t = a[e] - lam * c[e]; d[8 * j + e] = t; ss += t * t; } }
    ss += __shfl_xor(ss, 1);
    const float rstd = __builtin_amdgcn_rsqf(ss * (1.f / 128.f) + RMS_EPS) * 0.8f;
    v4u* op = (v4u*)(MIX + row * DMODEL + h * 128 + half * 64);
#pragma unroll
    for (int j = 0; j < 8; ++j) { const f32x4 g0 = *(const f32x4*)(gsub + half * 64 + 8 * j), g1 = *(const f32x4*)(gsub + half * 64 + 8 * j + 4);
        v4u w; w.x = pk2(d[8 * j + 0] * rstd * g0[0], d[8 * j + 1] * rstd * g0[1]); w.y = pk2(d[8 * j + 2] * rstd * g0[2], d[8 * j + 3] * rstd * g0[3]);
        w.z = pk2(d[8 * j + 4] * rstd * g1[0], d[8 * j + 5] * rstd * g1[1]); w.w = pk2(d[8 * j + 6] * rstd * g1[2], d[8 * j + 7] * rstd * g1[3]); op[j] = w; }
}

namespace ret {
constexpr int LP = 72;
constexpr int OFF_Q = 0, OFF_K = OFF_Q + 64 * LP * 2, OFF_KT = OFF_K + 64 * LP * 2, OFF_VT = OFF_KT + 64 * LP * 2, OFF_ST = OFF_VT + 128 * LP * 2, OFF_P = OFF_ST + 128 * LP * 2, OFF_O = OFF_P + 64 * LP * 2;
constexpr int OP_F = 132;
constexpr int BYTES = OFF_O + 64 * OP_F * 4;
static_assert(BYTES <= 131072, "retention LDS");
__device__ __forceinline__ f32x16v mma64(f32x16v acc, const LAS bf16* A, int arow, const LAS bf16* B, int brow, int lane) {
    const int r = lane & 31, hi = lane >> 5;
#pragma unroll
    for (int ks = 0; ks < 4; ++ks) { const bf16x8 a = *(const LAS bf16x8*)(A + (arow + r) * LP + ks * 16 + hi * 8), b = *(const LAS bf16x8*)(B + (brow + r) * LP + ks * 16 + hi * 8);
        acc = __builtin_amdgcn_mfma_f32_32x32x16_bf16(a, b, acc, 0, 0, 0); }
    return acc;
}
__device__ __forceinline__ int crow(int r, int hi) { return (r & 3) + 8 * (r >> 2) + 4 * hi; }

template <int PITCH, int KS>
__device__ __forceinline__ f32x16v mmaT(f32x16v acc, const LAS bf16* A, int arow, const LAS bf16* B, int brow, int lane) {
    const int r = lane & 31, hi = lane >> 5;
#pragma unroll
    for (int ks = 0; ks < KS; ++ks) { const bf16x8 a = *(const LAS bf16x8*)(A + (arow + r) * PITCH + ks * 16 + hi * 8), b = *(const LAS bf16x8*)(B + (brow + r) * PITCH + ks * 16 + hi * 8);
        acc = __builtin_amdgcn_mfma_f32_32x32x16_bf16(a, b, acc, 0, 0, 0); }
    return acc;
}
constexpr int TP = 264;
static_assert((64 + 128) * TP * 2 <= BYTES, "pre-pass images alias the main buffers");
__device__ __forceinline__ void unit(int b, int h, int seg, const bf16* PJ, bf16* MIX, LAS unsigned char* lds, int tid) {
    const int lane = tid & 63, wid = __builtin_amdgcn_readfirstlane(tid >> 6), hi = lane >> 5, l31 = lane & 31;
    LAS bf16* Qc = (LAS bf16*)(lds + OFF_Q); LAS bf16* Kc = (LAS bf16*)(lds + OFF_K); LAS bf16* KT = (LAS bf16*)(lds + OFF_KT); LAS bf16* VT = (LAS bf16*)(lds + OFF_VT);
    LAS bf16* ST = (LAS bf16*)(lds + OFF_ST); LAS bf16* Pm = (LAS bf16*)(lds + OFF_P); LAS float* Of = (LAS float*)(lds + OFF_O);
    LAS bf16* KT4 = (LAS bf16*)lds; LAS bf16* VT4 = (LAS bf16*)(lds + 64 * TP * 2);
    const float lg2 = __builtin_amdgcn_logf(1.f - __builtin_amdgcn_exp2f(-5.f - (float)h));
    const float cdec = __builtin_amdgcn_exp2f(lg2 * 64.f);
    const int n_start = seg * 8, n_end = seg * 8 + 8;
    const size_t rowb = (size_t)b * SEQ;
    f32x16v Sacc = (f32x16v){};
    if (seg > 0) {
        const int tok0 = tid >> 2, ch0 = tid & 3;
        const float cdec4 = __builtin_amdgcn_exp2f(lg2 * 256.f);
        const float dj0 = 0.125f * __builtin_amdgcn_exp2f(lg2 * (float)(255 - tok0)), dj1 = 0.125f * __builtin_amdgcn_exp2f(lg2 * (float)(127 - tok0));
        v4u kx[4], vx[8];
        { const bf16* rp = PJ + (rowb + tok0) * INW;
#pragma unroll
          for (int p = 0; p < 4; ++p) kx[p] = *(const v4u*)(rp + (size_t)(128 * (p & 1)) * INW + C_RK + h * 64 + (ch0 + 4 * (p >> 1)) * 8);
#pragma unroll
          for (int p = 0; p < 8; ++p) vx[p] = *(const v4u*)(rp + (size_t)(128 * (p & 1)) * INW + C_RV + h * 128 + (ch0 + 4 * (p >> 1)) * 8); }
        const int nblk = 2 * seg;
        for (int blk = 0; blk < nblk; ++blk) {
#pragma unroll
            for (int p = 0; p < 4; ++p) { float kf[8]; unpack8(kx[p], kf); LAS bf16* dst = KT4 + ((ch0 + 4 * (p >> 1)) * 8) * TP + tok0 + 128 * (p & 1); const float dj = (p & 1) ? dj1 : dj0;
#pragma unroll
                for (int e = 0; e < 8; ++e) dst[e * TP] = (bf16)f2bf(kf[e] * dj); }
#pragma unroll
            for (int p = 0; p < 8; ++p) { const v4u w = vx[p]; LAS bf16* dst = VT4 + ((ch0 + 4 * (p >> 1)) * 8) * TP + tok0 + 128 * (p & 1);
                dst[0 * TP] = (bf16)(w.x & 0xffffu); dst[1 * TP] = (bf16)(w.x >> 16); dst[2 * TP] = (bf16)(w.y & 0xffffu); dst[3 * TP] = (bf16)(w.y >> 16);
                dst[4 * TP] = (bf16)(w.z & 0xffffu); dst[5 * TP] = (bf16)(w.z >> 16); dst[6 * TP] = (bf16)(w.w & 0xffffu); dst[7 * TP] = (bf16)(w.w >> 16); }
            if (blk + 1 < nblk) { const bf16* rp = PJ + (rowb + (size_t)(blk + 1) * 256 + tok0) * INW;
#pragma unroll
                for (int p = 0; p < 4; ++p) kx[p] = *(const v4u*)(rp + (size_t)(128 * (p & 1)) * INW + C_RK + h * 64 + (ch0 + 4 * (p >> 1)) * 8);
#pragma unroll
                for (int p = 0; p < 8; ++p) vx[p] = *(const v4u*)(rp + (size_t)(128 * (p & 1)) * INW + C_RV + h * 128 + (ch0 + 4 * (p >> 1)) * 8); }
            __syncthreads();
#pragma unroll
            for (int r = 0; r < 16; ++r) Sacc[r] *= cdec4;
            Sacc = mmaT<TP, 16>(Sacc, KT4, 32 * (wid >> 2), VT4, 32 * (wid & 3), lane);
            __syncthreads();
        }
        const int dv = 32 * (wid & 3) + l31;
#pragma unroll
        for (int g = 0; g < 4; ++g) { v2u w; w.x = pk2(Sacc[4 * g + 0], Sacc[4 * g + 1]); w.y = pk2(Sacc[4 * g + 2], Sacc[4 * g + 3]);
            *(LAS v2u*)(ST + dv * LP + 32 * (wid >> 2) + 8 * g + 4 * hi) = w; }
    } else {
        for (int i = tid; i < 128 * LP / 2; i += 512) ((LAS unsigned*)ST)[i] = 0u;
    }
    const int tj = tid & 63, tc = tid >> 6;
    v4u q8, k8, v8[2];
    { const bf16* rp = PJ + (rowb + (size_t)n_start * 64 + tj) * INW; k8 = *(const v4u*)(rp + C_RK + h * 64 + tc * 8); q8 = *(const v4u*)(rp + C_RQ + h * 64 + tc * 8);
#pragma unroll
      for (int i = 0; i < 2; ++i) { const int idx = tid + 512 * i; v8[i] = *(const v4u*)(PJ + (rowb + (size_t)n_start * 64 + (idx & 63)) * INW + C_RV + h * 128 + (idx >> 6) * 8); } }
    for (int c = n_start; c < n_end; ++c) {
        { float kf[8]; unpack8(k8, kf); const float dj = 0.125f * __builtin_amdgcn_exp2f(lg2 * (float)(63 - tj));
#pragma unroll
          for (int e = 0; e < 8; ++e) KT[(tc * 8 + e) * LP + tj] = (bf16)f2bf(kf[e] * dj);
          { v4u w; w.x = pk2(kf[0] * 0.125f, kf[1] * 0.125f); w.y = pk2(kf[2] * 0.125f, kf[3] * 0.125f); w.z = pk2(kf[4] * 0.125f, kf[5] * 0.125f); w.w = pk2(kf[6] * 0.125f, kf[7] * 0.125f);
              *(LAS v4u*)(Kc + tj * LP + tc * 8) = w; *(LAS v4u*)(Qc + tj * LP + tc * 8) = q8; }
#pragma unroll
          for (int i = 0; i < 2; ++i) { const int idx = tid + 512 * i, vj = idx & 63, vc = idx >> 6; const v4u w = v8[i];
              VT[(vc * 8 + 0) * LP + vj] = (bf16)(w.x & 0xffffu); VT[(vc * 8 + 1) * LP + vj] = (bf16)(w.x >> 16); VT[(vc * 8 + 2) * LP + vj] = (bf16)(w.y & 0xffffu); VT[(vc * 8 + 3) * LP + vj] = (bf16)(w.y >> 16);
              VT[(vc * 8 + 4) * LP + vj] = (bf16)(w.z & 0xffffu); VT[(vc * 8 + 5) * LP + vj] = (bf16)(w.z >> 16); VT[(vc * 8 + 6) * LP + vj] = (bf16)(w.w & 0xffffu); VT[(vc * 8 + 7) * LP + vj] = (bf16)(w.w >> 16); } }
        __syncthreads();
        const size_t row0 = rowb + (size_t)c * 64;
        if (c + 1 < n_end) {
            const bf16* rp = PJ + (row0 + 64 + tj) * INW; k8 = *(const v4u*)(rp + C_RK + h * 64 + tc * 8); q8 = *(const v4u*)(rp + C_RQ + h * 64 + tc * 8);
#pragma unroll
            for (int i = 0; i < 2; ++i) { const int idx = tid + 512 * i; v8[i] = *(const v4u*)(PJ + (row0 + 64 + (idx & 63)) * INW + C_RV + h * 128 + (idx >> 6) * 8); }
        }
        v4u gq[2];
        const int ni = tid >> 3, np = tid & 7;
        { const bf16* gp = PJ + (row0 + ni) * INW + C_RG + h * 128 + np * 16; gq[0] = *(const v4u*)gp; gq[1] = *(const v4u*)(gp + 8); }
        if (wid < 4) {
            const int ti = wid >> 1, tjj = wid & 1;
            f32x16v sc = mma64((f32x16v){}, Qc, 32 * ti, Kc, 32 * tjj, lane);
            const int j = 32 * tjj + l31;
#pragma unroll
            for (int r = 0; r < 16; ++r) { const int i = 32 * ti + crow(r, hi); const int dd = i > j ? i - j : j - i;
                Pm[i * LP + j] = (bf16)f2bf(sc[r] * __builtin_amdgcn_exp2f(lg2 * (float)dd)); }
        }
        __syncthreads();
        { const int ti = wid >> 2, tn = wid & 3;
          f32x16v a1 = mma64((f32x16v){}, Pm, 32 * ti, VT, 32 * tn, lane);
          f32x16v a2 = mma64((f32x16v){}, Qc, 32 * ti, ST, 32 * tn, lane);
#pragma unroll
          for (int r = 0; r < 16; ++r) { const int i = 32 * ti + crow(r, hi); Of[i * OP_F + 32 * tn + l31] = a1[r] + __builtin_amdgcn_exp2f(lg2 * (float)(i + 1)) * a2[r]; } }
#pragma unroll
        for (int r = 0; r < 16; ++r) Sacc[r] *= cdec;
        Sacc = mma64(Sacc, KT, 32 * (wid >> 2), VT, 32 * (wid & 3), lane);
        __syncthreads();
        if (c + 1 < n_end) {
            const int dv = 32 * (wid & 3) + l31;
#pragma unroll
            for (int g = 0; g < 4; ++g) { v2u w; w.x = pk2(Sacc[4 * g + 0], Sacc[4 * g + 1]); w.y = pk2(Sacc[4 * g + 2], Sacc[4 * g + 3]);
                *(LAS v2u*)(ST + dv * LP + 32 * (wid >> 2) + 8 * g + 4 * hi) = w; }
        }
        {
            float o[16]; float ss = 0.f;
#pragma unroll
            for (int q = 0; q < 4; ++q) { const f32x4 t = *(const LAS f32x4*)(Of + ni * OP_F + np * 16 + 4 * q); o[4 * q] = t.x; o[4 * q + 1] = t.y; o[4 * q + 2] = t.z; o[4 * q + 3] = t.w;
                ss += (t.x * t.x + t.y * t.y) + (t.z * t.z + t.w * t.w); }
            ss += __shfl_xor(ss, 1); ss += __shfl_xor(ss, 2); ss += __shfl_xor(ss, 4);
            const float rstd = __builtin_amdgcn_rsqf(ss * (1.f / 128.f) + RMS_EPS);
            float gf[16]; { float t0[8], t1[8]; unpack8(gq[0], t0); unpack8(gq[1], t1);
#pragma unroll
                for (int e = 0; e < 8; ++e) { gf[e] = t0[e]; gf[8 + e] = t1[e]; } }
#pragma unroll
            for (int e = 0; e < 16; ++e) o[e] = o[e] * rstd * silu_f(gf[e]);
            bf16* op = MIX + (row0 + ni) * DMODEL + 512 + h * 128 + np * 16;
            v4u w0, w1; w0.x = pk2(o[0], o[1]); w0.y = pk2(o[2], o[3]); w0.z = pk2(o[4], o[5]); w0.w = pk2(o[6], o[7]); w1.x = pk2(o[8], o[9]); w1.y = pk2(o[10], o[11]); w1.z = pk2(o[12], o[13]); w1.w = pk2(o[14], o[15]);
            *(v4u*)op = w0; *(v4u*)(op + 8) = w1;
        }
    }
    __syncthreads();
}
}

#define XB_TMO      128
#define XB_XCNT(j)  (256  + 64 * (j))
#define XB_XSUB(j)  (1280 + 64 * (j))
#define XB_XGEN(j)  (2304 + 64 * (j))
#define XB_TOP      3328
#define XB_TOPGEN   3392
#define XCD_BAR_WORDS 3456
#define XB_SPIN_CAP (1u << 18)

__device__ __forceinline__ unsigned xb_ld(unsigned* p)              { return __hip_atomic_load(p, __ATOMIC_RELAXED, __HIP_MEMORY_SCOPE_AGENT); }
__device__ __forceinline__ unsigned xb_add(unsigned* p, unsigned v) { return __hip_atomic_fetch_add(p, v, __ATOMIC_RELAXED, __HIP_MEMORY_SCOPE_AGENT); }
__device__ __forceinline__ unsigned xb_xcc_id() { return (unsigned)__builtin_amdgcn_s_getreg((3 << 11) | 20) & 0xFu; }
#define XB_SPIN(cond, bar) do { unsigned _sp = 0; while (cond) { __builtin_amdgcn_s_sleep(1); \
    if ((++_sp & 255u) == 0u) { if (xb_ld(&(bar)[XB_TMO])) break; if (_sp > XB_SPIN_CAP) { atomicAdd(&(bar)[XB_TMO], 1u); break; } } } } while (0)

struct XcdBarrier {
    unsigned* bar; unsigned x;
    volatile LAS unsigned* st;
};

__device__ __forceinline__ XcdBarrier xcd_barrier_post(unsigned* bar, volatile LAS unsigned* st) {
    XcdBarrier b; b.bar = bar; b.x = xb_xcc_id(); b.st = st;
    if (threadIdx.x == 0) (void)xb_add(&bar[XB_XCNT(b.x)], 1u);
    return b;
}
__device__ __forceinline__ void xcd_barrier_complete(unsigned* bar, unsigned x, unsigned& nloc, unsigned& nx) {
    const unsigned G = gridDim.x * gridDim.y * gridDim.z;
    unsigned sum, cnt, mine, sp = 0u;
    for (;;) {
        sum = 0u; cnt = 0u; mine = 0u;
#pragma unroll
        for (unsigned j = 0; j < 16; ++j) { const unsigned c = xb_ld(&bar[XB_XCNT(j)]); sum += c; cnt += (c > 0u) ? 1u : 0u; mine = (j == x) ? c : mine; }
        if (sum == G) break;
        __builtin_amdgcn_s_sleep(1);
        if ((++sp & 255u) == 0u) { if (xb_ld(&bar[XB_TMO])) break; if (sp > XB_SPIN_CAP) { atomicAdd(&bar[XB_TMO], 1u); break; } }
    }
    nloc = mine > 0u ? mine : 1u; nx = cnt > 0u ? cnt : 1u;
}

__device__ __forceinline__ void xcd_barrier(const XcdBarrier& b) {
    asm volatile("s_waitcnt vmcnt(0)" ::: "memory");
    __syncthreads();
    if (threadIdx.x == 0) {
        unsigned* bar = b.bar;
        __builtin_amdgcn_s_waitcnt(0);
        unsigned nloc = b.st[0], nx = b.st[1];
        if (nloc == 0u) { xcd_barrier_complete(bar, b.x, nloc, nx); b.st[0] = nloc; b.st[1] = nx; }
        const unsigned old = xb_add(&bar[XB_XSUB(b.x)], 1u);
        const unsigned gen = old / nloc;
        if (old + 1u == (gen + 1u) * nloc) {
            __builtin_amdgcn_fence(__ATOMIC_RELEASE, "agent");
            asm volatile("s_waitcnt vmcnt(0)" ::: "memory");
            const unsigned og = xb_add(&bar[XB_TOP], 1u);
            const unsigned tg = og / nx;
            if (og + 1u == (tg + 1u) * nx) xb_add(&bar[XB_TOPGEN], 1u);
            else XB_SPIN(xb_ld(&bar[XB_TOPGEN]) == tg, bar);
            __builtin_amdgcn_fence(__ATOMIC_ACQUIRE, "agent");
            xb_add(&bar[XB_XGEN(b.x)], 1u);
            asm volatile("s_waitcnt vmcnt(0)" ::: "memory");
        } else {
            XB_SPIN(xb_ld(&bar[XB_XGEN(b.x)]) == gen, bar);
            __builtin_amdgcn_fence(__ATOMIC_ACQUIRE, "agent");
            asm volatile("s_waitcnt vmcnt(0)" ::: "memory");
        }
    }
    __syncthreads();
}

__global__ void __launch_bounds__(NWAVES * 64, 2) fwd_kernel(Args args) {
    extern __shared__ __attribute__((aligned(16))) unsigned char lds[];
    { volatile LAS unsigned* st0 = (volatile LAS unsigned*)((LAS unsigned char*)lds + LDS_BYTES - 16); if (threadIdx.x < 4) st0[threadIdx.x] = 0u; }
    __syncthreads();
    if (args.ph_hi - args.ph_lo > 1) (void)xcd_barrier_post((unsigned*)(args.ws + WS_CTL), (volatile LAS unsigned*)((LAS unsigned char*)lds + LDS_BYTES - 16));
#define TID tl_
#define LANE (TID & 63)
#define WAVE (__builtin_amdgcn_readfirstlane(TID >> 6))
#define GRID gl_
#define BX bxl_
#define VCU ((GRID % 8 == 0) ? (BX % 8) * (GRID / 8) + BX / 8 : BX)
#define GW (VCU * NWAVES + WAVE)
#define NGW (GRID * NWAVES)
#define LDSP ((LAS unsigned char*)lds)
#define ARGIN(i) (((const float* const __attribute__((address_space(4)))*)kp_)[i])
#define ARGOUT (((float* const __attribute__((address_space(4)))*)kp_)[19])
#define WSP(off) ((bf16*)(wsl_ + (off)))
#define MODP ((float*)(wsl_ + WS_MOD))
#ifndef PHMASK
#define PHMASK 0x3ff
#endif
#define IN(k) (((PHMASK >> (k)) & 1) && args.ph_lo <= (k) && (k) < args.ph_hi)
#define SEAM(k) do { if (args.ph_lo <= (k) && (k) + 1 < args.ph_hi) { cg::this_grid().sync(); } } while (0)

  for (int ph = args.ph_lo; ph < args.ph_hi; ++ph) {
    if (ph == 7) continue;
    int tl_ = (int)threadIdx.x; asm volatile("" : "+v"(tl_));
    int bxl_ = (int)blockIdx.x; asm volatile("" : "+s"(bxl_));
    int gl_ = (int)gridDim.x; asm volatile("" : "+s"(gl_));
    const __attribute__((address_space(4))) unsigned char* kp_ = (const __attribute__((address_space(4))) unsigned char*)__builtin_amdgcn_kernarg_segment_ptr(); asm volatile("" : "+s"(kp_));
    unsigned char* wsl_ = ((unsigned char* const __attribute__((address_space(4)))*)kp_)[20];
    if (ph == 2 || ph == 4 || ph == 6 || ph == 8) {
        size_t oa = WS_XN, ob = WS_WIN, oc = WS_PROJ; int N = INW, K = DMODEL, lda = DMODEL, ldc = INW, scols = 512, mode = 0; float sc0 = 0.125f * LOG2E;
        if (ph == 4) { oa = WS_MIX; ob = WS_WOUT; oc = WS_Y; N = DMODEL; ldc = DMODEL; scols = 0; sc0 = 1.f; }
        if (ph == 6) { oa = WS_XN; ob = WS_WUP; oc = WS_A2; N = FF2; ldc = FF; scols = 0; sc0 = 1.f; mode = 1; }
        if (ph == 8) { oa = WS_A2; ob = WS_WDN; oc = WS_F; N = DMODEL; K = FF; lda = FF; ldc = DMODEL; scols = 0; sc0 = 1.f; }
        pg8::Gemm g{WSP(oa), WSP(ob), M, N, K, lda}; pg8::StaticOrder S; S.init(M, N, GRID, BX, (N == DMODEL) ? 8 : 4);
        if (ph == 8) {
            pg8::Unit u_;
            for (int i = 0; S.next(i, u_); ++i) conv_fixup(u_.pm, (const float*)(wsl_ + WS_RAWF), (const float*)(wsl_ + WS_RAWL), ARGIN(I_CONVW), ARGIN(I_CONVB), WSP(WS_A2), TID);
            VM_WAIT(); __syncthreads();
        }
        pg8::EpiBf16 E{WSP(oc), ldc, scols, sc0, mode, ARGIN(I_CONVW), ARGIN(I_CONVB), (float*)(wsl_ + WS_RAWF), (float*)(wsl_ + WS_RAWL), (LAS float*)(LDSP + 131072)};
        pg8::gemm_phase<pg8::EpiBf16, pg8::StaticOrder, true, true>(LDSP, g, S, E, TID);
    } else if (ph == 0) {
        const int lane = LANE, wave = WAVE, gw = GW, ngw = NGW;
        LAS float* scr = (LAS float*)(LDSP + wave * 16384);
        constexpr int T_IN = (DMODEL / 64) * (INW / 32), T_OUT = (DMODEL / 64) * (DMODEL / 32), T_UP = (DMODEL / 64) * (FF2 / 32), T_DN = (FF / 64) * (DMODEL / 32), T_MOD = 96 * 16;
        constexpr int NITEMS = T_IN + T_OUT + T_UP + T_DN + T_MOD;
        for (int it = gw; it < NITEMS; it += ngw) {
            int r = it;
            if (r < T_MOD) { p0_mod_item(ARGIN(I_C), ARGIN(I_WADA), ARGIN(I_BADA), MODP, scr, r, lane); continue; } r -= T_MOD;
            const float* W = ARGIN(I_WIN); int K = DMODEL, N = INW; size_t wo = WS_WIN; bool pu = false;
            if (r >= T_IN) { r -= T_IN; W = ARGIN(I_WOUT); N = DMODEL; wo = WS_WOUT;
                if (r >= T_OUT) { r -= T_OUT; W = ARGIN(I_WUP); N = FF2; wo = WS_WUP; pu = true;
                    if (r >= T_UP) { r -= T_UP; W = ARGIN(I_WDOWN); K = FF; N = DMODEL; wo = WS_WDN; pu = false; } } }
            p0_transpose_item(W, K, N, WSP(wo), scr, r, lane, pu);
        }
        if (BX == 0 && wave == 0) {
            const float a = ARGIN(I_LQ1)[lane] * ARGIN(I_LK1)[lane], b2 = ARGIN(I_LQ2)[lane] * ARGIN(I_LK2)[lane];
            const float sa = wave_sum(a), sb = wave_sum(b2);
            if (lane == 0) (MODP + 8 * NMOD)[0] = __expf(sa) - __expf(sb) + 0.2f;
        }
    } else if (ph == 1) {
        const int lane = LANE, ngw = NGW;
        p1_rows(ARGIN(I_X), ARGIN(I_GPREMIX), MODP, WSP(WS_XN), GW, ngw, lane);
    } else if (ph == 3) {
        for (int it = BX; it < 512; it += GRID) {
            const int slot = it & 255, rnd = it >> 8; const int xq = slot & 7, cq = slot >> 3;
            const int bh = 4 * xq + 2 * rnd + (cq >> 4), jq = cq & 15, b = bh >> 2, h = bh & 3;
            const int qb = (int)(((rnd == 0 ? 0x10a864fedcb97532ull : 0xcd468a0123579befull) >> (4 * jq)) & 15ull);
#ifndef P3_NO_ATTN
#pragma unroll 1
            for (int sub = 0; sub < 4; ++sub) {
                const int mm = ((sub + 1) >> 1) & 1, vh = sub >> 1;
                attn_body::attn_unit<100>(b, C_DAQ + h * 128 + mm * 64, C_DAK + h * 128 + mm * 64, C_DAV + h * 128 + vh * 64, (h * 4 + mm * 2 + vh) * 64, h, qb,
                                        (const attn_body::bf16*)WSP(WS_PROJ), (attn_body::bf16*)WSP(WS_OTMP), (char*)lds, TID);
            }
#endif
            VM_WAIT(); __syncthreads();
#ifndef P3_NO_COMB
            { int tc_ = TID; asm volatile("" : "+v"(tc_)); da_combine(b, h, qb, WSP(WS_OTMP), WSP(WS_MIX), ARGIN(I_GSUB), (MODP + 8 * NMOD)[0], tc_); }
#endif
            __syncthreads();
        }
#ifndef P3_NO_RET
        for (int it = BX; it < 256; it += GRID) {
            const int xr = it & 7, cr = it >> 3, bhr = 4 * xr + 2 * (cr >> 4) + (cr & 1), segr = (cr & 15) >> 1;
            int tr_ = TID; asm volatile("" : "+v"(tr_));
            ret::unit(bhr >> 2, bhr & 3, segr, WSP(WS_PROJ), WSP(WS_MIX), LDSP, tr_);
        }
#endif
    } else if (ph == 5) {
        const int lane = LANE, ngw = NGW;
        p5_rows(ARGIN(I_X), WSP(WS_Y), ARGIN(I_GPOSTMIX), ARGIN(I_GPREFFN), MODP, WSP(WS_X1B), WSP(WS_XN), GW, ngw, lane);
    } else if (ph == 9) {
        const int lane = LANE, ngw = NGW;
        p9_rows(ARGOUT, WSP(WS_X1B), WSP(WS_F), ARGIN(I_GPOSTFFN), MODP, GW, ngw, lane);
    }
    if (ph + 1 < args.ph_hi) {
        if (args.ph_hi > 64) cg::this_grid().sync();
        else { XcdBarrier xb_; xb_.bar = (unsigned*)(wsl_ + WS_CTL); xb_.x = xb_xcc_id(); xb_.st = (volatile LAS unsigned*)((LAS unsigned char*)lds + LDS_BYTES - 16); xcd_barrier(xb_); }
    }
  }
#undef IN
#undef SEAM
}

extern "C" void kernel_launch(void* const* d_in, const int* in_sizes, int n_in, void* d_out, int out_size, void* d_ws, size_t ws_size, hipStream_t stream) {
    static int grid = 0;
    if (grid == 0) {
        if (n_in != 19 || in_sizes[0] != M * DMODEL || out_size != M * DMODEL || ws_size < WS_END) {
            fprintf(stderr, "kernel_launch: unexpected shapes: n_in %d in0 %d out %d ws %zu (need >= %zu)\n", n_in, n_in > 0 ? in_sizes[0] : -1, out_size, ws_size, (size_t)WS_END); grid = -1; return; }
        int dev = 0, cus = 0, per_cu = 0;
        hipGetDevice(&dev); hipDeviceGetAttribute(&cus, hipDeviceAttributeMultiprocessorCount, dev);
        if (hipFuncSetAttribute((const void*)fwd_kernel, hipFuncAttributeMaxDynamicSharedMemorySize, LDS_BYTES) != hipSuccess) fprintf(stderr, "kernel_launch: hipFuncSetAttribute failed\n");
        if (hipOccupancyMaxActiveBlocksPerMultiprocessor(&per_cu, (const void*)fwd_kernel, NWAVES * 64, LDS_BYTES) != hipSuccess || per_cu < 1) { fprintf(stderr, "kernel_launch: occupancy query gave %d\n", per_cu); per_cu = 1; }
        (void)hipGetLastError();
        grid = cus * (per_cu > 1 ? 1 : per_cu);
        if (grid <= 0) grid = 256;
    }
    if (grid < 0) return;
    hipMemsetAsync((char*)d_ws + WS_CTL, 0, CTL_ZERO_BYTES + (size_t)8 * NMOD * 4, stream);
    Args a{};
    for (int i = 0; i < 19; ++i) a.in[i] = (const float*)d_in[i];
    a.out = (float*)d_out; a.ws = (unsigned char*)d_ws;
#if MK_N_LAUNCHES == 1
    a.ph_lo = 0; a.ph_hi = 10;
    void* kargs[] = {&a};
    hipError_t e = hipLaunchCooperativeKernel((const void*)fwd_kernel, dim3(grid), dim3(NWAVES * 64), kargs, LDS_BYTES, stream);
    if (e != hipSuccess) fprintf(stderr, "cooperative launch failed: %s (grid %d)\n", hipGetErrorString(e), grid);
#else
    for (int p = 0; p < 10; ++p) { a.ph_lo = p; a.ph_hi = p + 1; hipLaunchKernelGGL(fwd_kernel, dim3(grid), dim3(NWAVES * 64), LDS_BYTES, stream, a); }
#endif
}
```
